# Optimizing an MI355X kernel written in HIP

```python
import jax, jax.numpy as jnp
from jax import lax
import numpy as np

D_MODEL = 1024
BATCH = 8
SEQ = 2048
DEPTH = 4

N_A_LAYERS = DEPTH // 2
N_B_LAYERS = DEPTH - N_A_LAYERS

HG_HEADS = 8
HG_DK = 128
HG_DV = D_MODEL // HG_HEADS
HG_KEY_WIDTH = HG_HEADS * HG_DK
HG_VAL_WIDTH = HG_HEADS * HG_DV
HG_CHUNK = 64

SWA_Q_HEADS = 16
SWA_KV_HEADS = 4
SWA_GROUP = SWA_Q_HEADS // SWA_KV_HEADS
SWA_HEAD_DIM = 64
SWA_WIDTH = SWA_Q_HEADS * SWA_HEAD_DIM
SWA_KV_WIDTH = SWA_KV_HEADS * SWA_HEAD_DIM
WINDOW = 128
SWA_BLOCK = WINDOW

MEM_TOKENS = 256
MEM_HEADS = 4
MEM_HEAD_DIM = 128
MEM_WIDTH = MEM_HEADS * MEM_HEAD_DIM

ROPE_THETA = 10000.0
NORM_EPS = 1e-6

A_IN_SPLITS = (HG_KEY_WIDTH, HG_KEY_WIDTH, HG_VAL_WIDTH, HG_VAL_WIDTH, MEM_WIDTH, MEM_WIDTH)
B_IN_SPLITS = (SWA_WIDTH, SWA_WIDTH, MEM_WIDTH, MEM_WIDTH)
A_IN_WIDTH = sum(A_IN_SPLITS)
B_IN_WIDTH = sum(B_IN_SPLITS)
A_OUT_WIDTH = HG_VAL_WIDTH + MEM_WIDTH
B_OUT_WIDTH = SWA_WIDTH + MEM_WIDTH

kernel_name = "yoco_hgrn2_swa_sink_memory_trunk"


def rms_norm(x, g):
    xf = x.astype(jnp.float32)
    y = xf * lax.rsqrt(jnp.mean(xf * xf, axis=-1, keepdims=True) + NORM_EPS)
    return (y * g.astype(jnp.float32)).astype(x.dtype)


def split_cols(z, sizes):
    return jnp.split(z, list(np.cumsum(sizes)[:-1]), axis=-1)


def rope_tables(positions, dim):
    inv_freq = ROPE_THETA ** (-jnp.arange(0, dim, 2, dtype=jnp.float32) / dim)
    ang = positions.astype(jnp.float32)[..., None] * inv_freq
    return jnp.cos(ang), jnp.sin(ang)


def apply_rope(x, cos, sin):
    xf = x.astype(jnp.float32)
    x1, x2 = jnp.split(xf, 2, axis=-1)
    c = cos[:, :, None, :]
    s = sin[:, :, None, :]
    return jnp.concatenate([x1 * c - x2 * s, x2 * c + x1 * s], axis=-1).astype(x.dtype)


def memory_attention(mq, mem_n, w_mem_kv):
    b, s, _ = mq.shape
    q = mq.reshape(b, s, MEM_HEADS, MEM_HEAD_DIM)
    kv = jnp.einsum('bmd,de->bme', mem_n, w_mem_kv)
    k, v = jnp.split(kv, 2, axis=-1)
    k = k.reshape(b, -1, MEM_HEADS, MEM_HEAD_DIM)
    v = v.reshape(b, -1, MEM_HEADS, MEM_HEAD_DIM)
    scores = jnp.einsum('bshd,bmhd->bhsm', q, k).astype(jnp.float32) * (MEM_HEAD_DIM ** -0.5)
    p = jax.nn.softmax(scores, axis=-1)
    o = jnp.einsum('bhsm,bmhd->bshd', p.astype(v.dtype), v)
    return o.reshape(b, s, MEM_WIDTH)


def hgrn2_mixer(q_pre, f_pre, i_in, lb, out_norm_g):
    b, s, _ = q_pre.shape
    n_chunks = s // HG_CHUNK
    lbf = lb.astype(jnp.float32).reshape(HG_HEADS, HG_DK)
    fp = f_pre.astype(jnp.float32).reshape(b, s, HG_HEADS, HG_DK)
    log_f = jnp.logaddexp(jnp.log(lbf), jnp.log1p(-lbf) + jax.nn.log_sigmoid(fp))
    k = (1.0 - lbf) * jax.nn.sigmoid(-fp)
    q = jax.nn.silu(q_pre.astype(jnp.float32)).reshape(b, s, HG_HEADS, HG_DK)
    v = i_in.astype(jnp.float32).reshape(b, s, HG_HEADS, HG_DV)

    def to_chunks(t):
        return t.reshape(b, n_chunks, HG_CHUNK, HG_HEADS, -1).transpose(1, 0, 3, 2, 4)

    causal = jnp.tril(jnp.ones((HG_CHUNK, HG_CHUNK), dtype=bool))

    def step(state, xs):
        qc, kc, vc, lfc = xs
        cum = jnp.cumsum(lfc, axis=2)
        inter = jnp.einsum('bhtk,bhkv->bhtv', qc * jnp.exp(cum), state)
        diff = cum[:, :, :, None, :] - cum[:, :, None, :, :]
        decay = jnp.exp(jnp.where(causal[:, :, None], diff, -jnp.inf))
        scores = jnp.einsum('bhtsk,bhsk->bhts', qc[:, :, :, None, :] * decay, kc)
        intra = jnp.einsum('bhts,bhsv->bhtv', scores, vc)
        last = cum[:, :, -1, :]
        k_dec = kc * jnp.exp(last[:, :, None, :] - cum)
        state = jnp.exp(last)[..., None] * state + jnp.einsum('bhsk,bhsv->bhkv', k_dec, vc)
        return state, inter + intra

    state0 = jnp.zeros((b, HG_HEADS, HG_DK, HG_DV), jnp.float32)
    _, o = lax.scan(step, state0, (to_chunks(q), to_chunks(k), to_chunks(v), to_chunks(log_f)))
    o = o.transpose(1, 0, 3, 2, 4).reshape(b, s, HG_HEADS, HG_DV)
    o = o * lax.rsqrt(jnp.mean(o * o, axis=-1, keepdims=True) + NORM_EPS)
    o = o * out_norm_g.astype(jnp.float32).reshape(HG_HEADS, HG_DV)
    return o.reshape(b, s, HG_VAL_WIDTH).astype(q_pre.dtype)


def sliding_window_sink_attention(q, k, v, sinks):
    b, s = q.shape[:2]
    nb = s // SWA_BLOCK
    qb = q.reshape(b, nb, SWA_BLOCK, SWA_KV_HEADS, SWA_GROUP, SWA_HEAD_DIM)
    kb = k.reshape(b, nb, SWA_BLOCK, SWA_KV_HEADS, SWA_HEAD_DIM)
    vb = v.reshape(b, nb, SWA_BLOCK, SWA_KV_HEADS, SWA_HEAD_DIM)
    pad_k = jnp.zeros_like(kb[:, :1])
    pad_v = jnp.zeros_like(vb[:, :1])
    k2 = jnp.concatenate([jnp.concatenate([pad_k, kb[:, :-1]], axis=1), kb], axis=2)
    v2 = jnp.concatenate([jnp.concatenate([pad_v, vb[:, :-1]], axis=1), vb], axis=2)
    scores = jnp.einsum('bnqhgd,bnkhd->bnhgqk', qb, k2).astype(jnp.float32) * (SWA_HEAD_DIM ** -0.5)
    blk = jnp.arange(nb)[:, None, None]
    qpos = blk * SWA_BLOCK + jnp.arange(SWA_BLOCK)[None, :, None]
    kpos = (blk - 1) * SWA_BLOCK + jnp.arange(2 * SWA_BLOCK)[None, None, :]
    dist = qpos - kpos
    mask = (dist >= 0) & (dist < WINDOW) & (kpos >= 0)
    scores = jnp.where(mask[None, :, None, None], scores, -jnp.inf)
    sink = sinks.astype(jnp.float32).reshape(SWA_KV_HEADS, SWA_GROUP)[None, None, :, :, None, None]
    m = jnp.maximum(jnp.max(scores, axis=-1, keepdims=True), sink)
    p = jnp.exp(scores - m)
    p = p / (jnp.sum(p, axis=-1, keepdims=True) + jnp.exp(sink - m))
    o = jnp.einsum('bnhgqk,bnkhd->bnqhgd', p.astype(v2.dtype), v2)
    return o.reshape(b, s, SWA_WIDTH)


def shared_kv(h, kv_norm_g, w_kv_shared, cos, sin):
    b, s, _ = h.shape
    kv = jnp.einsum('bsd,de->bse', rms_norm(h, kv_norm_g), w_kv_shared)
    k, v = jnp.split(kv, 2, axis=-1)
    k = apply_rope(k.reshape(b, s, SWA_KV_HEADS, SWA_HEAD_DIM), cos, sin)
    v = v.reshape(b, s, SWA_KV_HEADS, SWA_HEAD_DIM)
    return k, v


def setup_inputs(seed: int = 0) -> dict:
    key = jax.random.key(seed)
    ks = jax.random.split(key, 20)

    def nrm(k, shape, scale):
        return jax.random.normal(k, shape, jnp.float32) * scale

    x = nrm(ks[0], (BATCH, SEQ, D_MODEL), 1.0)
    mem = nrm(ks[1], (BATCH, MEM_TOKENS, D_MODEL), 1.0)
    offsets = jax.random.randint(ks[2], (BATCH, 1), 0, 4096, dtype=jnp.int32)
    positions = offsets + jnp.arange(SEQ, dtype=jnp.int32)[None, :]
    return {
        "x": x,
        "mem": mem,
        "positions": positions,
        "pre_norm_g": 1.0 + nrm(ks[3], (DEPTH, D_MODEL), 0.02),
        "post_norm_g": 1.0 + nrm(ks[4], (DEPTH, D_MODEL), 0.02),
        "mem_norm_g": 1.0 + nrm(ks[5], (DEPTH, D_MODEL), 0.02),
        "w_mem_kv": nrm(ks[6], (DEPTH, D_MODEL, 2 * MEM_WIDTH), D_MODEL ** -0.5),
        "a_w_in": nrm(ks[7], (N_A_LAYERS, D_MODEL, A_IN_WIDTH), D_MODEL ** -0.5),
        "a_lb_logits": nrm(ks[8], (N_A_LAYERS + 1, HG_KEY_WIDTH), 0.5),
        "a_out_norm_g": 1.0 + nrm(ks[9], (N_A_LAYERS, HG_VAL_WIDTH), 0.02),
        "a_w_out": nrm(ks[10], (N_A_LAYERS, A_OUT_WIDTH, D_MODEL), A_OUT_WIDTH ** -0.5),
        "kv_norm_g": 1.0 + nrm(ks[11], (D_MODEL,), 0.02),
        "w_kv_shared": nrm(ks[12], (D_MODEL, 2 * SWA_KV_WIDTH), D_MODEL ** -0.5),
        "b_w_in": nrm(ks[13], (N_B_LAYERS, D_MODEL, B_IN_WIDTH), D_MODEL ** -0.5),
        "b_sinks": nrm(ks[14], (N_B_LAYERS, SWA_Q_HEADS), 0.5),
        "b_w_out": nrm(ks[15], (N_B_LAYERS, B_OUT_WIDTH, D_MODEL), B_OUT_WIDTH ** -0.5),
    }


def reference(x, mem, positions, pre_norm_g, post_norm_g, mem_norm_g, w_mem_kv,
              a_w_in, a_lb_logits, a_out_norm_g, a_w_out,
              kv_norm_g, w_kv_shared, b_w_in, b_sinks, b_w_out):
    b, s, _ = x.shape
    cos, sin = rope_tables(positions, SWA_HEAD_DIM)
    lb_all = jnp.cumsum(jax.nn.softmax(a_lb_logits.astype(jnp.float32), axis=0), axis=0)
    h = x
    k_sh = None
    v_sh = None
    for layer in range(DEPTH):
        xn = rms_norm(h, pre_norm_g[layer])
        mem_n = rms_norm(mem, mem_norm_g[layer])
        if layer < N_A_LAYERS:
            z = jnp.einsum('bsd,de->bse', xn, a_w_in[layer])
            q_pre, f_pre, i_in, g_main, mq, g_mem = split_cols(z, A_IN_SPLITS)
            o_main = hgrn2_mixer(q_pre, f_pre, i_in, lb_all[layer], a_out_norm_g[layer])
            o_main = o_main * jax.nn.silu(g_main)
            o_mem = memory_attention(mq, mem_n, w_mem_kv[layer]) * jax.nn.silu(g_mem)
            y = jnp.einsum('bse,ed->bsd', jnp.concatenate([o_main, o_mem], axis=-1), a_w_out[layer])
        else:
            if layer == N_A_LAYERS:
                k_sh, v_sh = shared_kv(h, kv_norm_g, w_kv_shared, cos, sin)
            j = layer - N_A_LAYERS
            z = jnp.einsum('bsd,de->bse', xn, b_w_in[j])
            q, g_main, mq, g_mem = split_cols(z, B_IN_SPLITS)
            q = apply_rope(q.reshape(b, s, SWA_Q_HEADS, SWA_HEAD_DIM), cos, sin)
            o_main = sliding_window_sink_attention(q, k_sh, v_sh, b_sinks[j]) * jax.nn.silu(g_main)
            o_mem = memory_attention(mq, mem_n, w_mem_kv[layer]) * jax.nn.silu(g_mem)
            y = jnp.einsum('bse,ed->bsd', jnp.concatenate([o_main, o_mem], axis=-1), b_w_out[j])
        h = h + rms_norm(y, post_norm_g[layer])
    return h
```

```cpp
#include <hip/hip_runtime.h>
#include <hip/hip_cooperative_groups.h>
#include <cstdio>
#include <cstdint>
namespace cg = cooperative_groups;
namespace pg8 {
#define PG8_LAS __attribute__((address_space(3)))
typedef unsigned short bf16_t;
typedef short bf16x8 __attribute__((ext_vector_type(8)));
typedef float f32x4 __attribute__((ext_vector_type(4)));
typedef unsigned u32x4 __attribute__((ext_vector_type(4)));
constexpr int BM = 256, BK = 64, HALF = 128, HTB = HALF * BK * 2  , STAGE_BYTES = 8 * HTB, NXCD = 8, WGM = 8;

__host__ __device__ __forceinline__ int lds_byte(int r, int c) { const int st = (r >> 4) * 2 + (c >> 5), rr = r & 15, cc = c & 31, ob = rr * 64 + cc * 2; return st * 1024 + (ob ^ (((ob >> 9) & 1) << 5)); }
__host__ __device__ __forceinline__ void stage_rc(int b, int& R, int& C) { const int st = b / 1024, sb = b % 1024, swz = sb ^ (((sb >> 9) & 1) << 5); R = (st >> 1) * 16 + swz / 64; C = (st & 1) * 32 + (swz % 64) / 2; }
__host__ __device__ __forceinline__ int perm32(int rho) { const int n = rho >> 4, i = rho & 15; return 8 * (i >> 2) + 4 * n + (i & 3); }

struct Unit { int pm, pn; };
struct Gemm { const bf16_t* A; const bf16_t* Bt; int M, N, K, lda; };

struct StaticOrder {
    int nM, nN, nwg, G, c;
    __host__ __device__ void init(int M, int N, int G_, int c_) { nM = M / BM; nN = N / BM; nwg = nM * nN; G = G_; c = c_; }
    __host__ __device__ bool next(int i, Unit& u) const {
        const long L = (long)i * G + c; if (L >= nwg) return false;
        int wgid = (int)L; { const int q = nwg / NXCD, r = nwg % NXCD, xcd = wgid % NXCD, off = wgid / NXCD; wgid = (xcd < r ? xcd * (q + 1) : r * (q + 1) + (xcd - r) * q) + off; }
        const int nig = WGM * nN, gid = wgid / nig, fm = gid * WGM, gsz = (nM - fm) < WGM ? (nM - fm) : WGM;
        u.pm = fm + ((wgid % nig) % gsz); u.pn = (wgid % nig) / gsz; return true;
    }
    __device__ __forceinline__ void a_ready(const Unit&) const {}
    __device__ __forceinline__ void done(const Unit&) const {}
};

__device__ __forceinline__ unsigned cvt_pk_bf16(float lo, float hi) { unsigned r; asm volatile("v_cvt_pk_bf16_f32 %0, %1, %2" : "=v"(r) : "v"(lo), "v"(hi)); return r; }
template <class Epi, class Sched, bool ALIGN_EPI, bool SP2, int KC, int LDAC>
__device__ __forceinline__ void gemm_phase(PG8_LAS unsigned char* lds, const Gemm g, const Sched& S, const Epi& E) {
    const int tid = threadIdx.x, wid = __builtin_amdgcn_readfirstlane(tid >> 6), lane = tid & 63, wr = wid >> 2, wc = wid & 3, fr = lane & 15, fq = lane >> 4;
    constexpr int K = KC, nt = K / BK;
    unsigned voffA, voffB;
    { int R, C; stage_rc(tid * 16, R, C); const int Rb = Epi::PERM ? ((R & ~31) + perm32(R & 31)) : R;
        voffA = (unsigned)(R * LDAC + C) * 2u; voffB = (unsigned)(Rb * K + C) * 2u; }
    constexpr size_t p2offA = (size_t)64 * LDAC * 2, p2offB = (size_t)64 * K * 2;
    const size_t kstep = (size_t)(BK * 2);
    const size_t hstepA = (size_t)HALF * LDAC * 2, hstepB = (size_t)HALF * K * 2;
    const size_t tstepA = 2 * hstepA, tstepB = 2 * hstepB;
    const unsigned ldsw = (unsigned)wid * 1024u;
    const int aoff = lds_byte(wr * 64 + fr, fq * 8), boff = lds_byte(wc * 32 + fr, fq * 8);
#define PG8_SA(b, h) (((b) * 2 + (h)) * HTB)
#define PG8_SB(b, h) ((4 + (b) * 2 + (h)) * HTB)
#define PG8_STAGE(bufoff, gbase, voff) do { _Pragma("unroll") for (int _i = 0; _i < 2; ++_i) \
        __builtin_amdgcn_global_load_lds((const unsigned*)((const char*)(gbase) + (size_t)_i * p2##voff + (v##voff)), (PG8_LAS unsigned*)(lds + (bufoff) + ldsw + _i * 8192), 16, 0, 0); } while (0)
#define PG8_LDA(dst, b, h) do { _Pragma("unroll") for (int m = 0; m < 4; ++m) _Pragma("unroll") for (int k = 0; k < 2; ++k) dst[m][k] = *(const PG8_LAS bf16x8*)(lds + PG8_SA(b, h) + aoff + m * 2048 + k * 1024); } while (0)
#define PG8_LDB(dst, b, h) do { _Pragma("unroll") for (int n = 0; n < 2; ++n) _Pragma("unroll") for (int k = 0; k < 2; ++k) dst[n][k] = *(const PG8_LAS bf16x8*)(lds + PG8_SB(b, h) + boff + n * 2048 + k * 1024); } while (0)
#define PG8_MMA(ai, bj, At, Bt) do { __builtin_amdgcn_s_setprio(1); _Pragma("unroll") for (int m = 0; m < 4; ++m) _Pragma("unroll") for (int n = 0; n < 2; ++n) _Pragma("unroll") for (int k = 0; k < 2; ++k) \
        acc[ai][bj][m][n] = __builtin_amdgcn_mfma_f32_16x16x32_bf16(Bt[n][k], At[m][k], acc[ai][bj][m][n], 0, 0, 0); __builtin_amdgcn_s_setprio(0); } while (0)
#define PG8_WAIT_V(n) asm volatile("s_waitcnt vmcnt(" #n ")" ::: "memory")
#define PG8_WAIT_L(n) asm volatile("s_waitcnt lgkmcnt(" #n ")" ::: "memory")
#define PG8_BAR __builtin_amdgcn_s_barrier()
#define PG8_SCHED __builtin_amdgcn_sched_barrier(0)
    Unit cur, nxt; int ui = 0;
    if (!S.next(0, cur)) return;
    f32x4 acc[2][2][4][2];
#pragma unroll
    for (int a = 0; a < 2; ++a)
#pragma unroll
        for (int b = 0; b < 2; ++b)
#pragma unroll
            for (int m = 0; m < 4; ++m)
#pragma unroll
                for (int n = 0; n < 2; ++n) acc[a][b][m][n] = (f32x4){0.f, 0.f, 0.f, 0.f};
    bf16x8 At[4][2], B0[2][2], B1[2][2];
    const char* cA = (const char*)g.A + (size_t)cur.pm * tstepA; const char* cB = (const char*)g.Bt + (size_t)cur.pn * tstepB;
    S.a_ready(cur);
    if constexpr (SP2) {
        PG8_STAGE(PG8_SB(0, 0), cB, offB); PG8_STAGE(PG8_SB(0, 1), cB + hstepB, offB); PG8_STAGE(PG8_SA(0, 0), cA, offA); PG8_STAGE(PG8_SA(0, 1), cA + hstepA, offA);
        if (wr == 1) PG8_BAR;
        PG8_WAIT_V(2); PG8_BAR;
        PG8_STAGE(PG8_SB(1, 0), cB + kstep, offB); PG8_STAGE(PG8_SA(1, 0), cA + kstep, offA); PG8_STAGE(PG8_SB(1, 1), cB + hstepB + kstep, offB);
        PG8_WAIT_V(6); PG8_BAR;
    } else {
        PG8_STAGE(PG8_SB(0, 0), cB, offB); PG8_STAGE(PG8_SA(0, 0), cA, offA); PG8_STAGE(PG8_SB(0, 1), cB + hstepB, offB); PG8_STAGE(PG8_SA(0, 1), cA + hstepA, offA);
        if (wr == 1) PG8_BAR;
        PG8_WAIT_V(4); PG8_BAR;
        PG8_STAGE(PG8_SB(1, 0), cB + kstep, offB); PG8_STAGE(PG8_SA(1, 0), cA + kstep, offA); PG8_STAGE(PG8_SB(1, 1), cB + hstepB + kstep, offB);
        PG8_WAIT_V(6); PG8_BAR;
    }
    for (;;) {
        const bool has_next = S.next(ui + 1, nxt);
        const char* nA = has_next ? (const char*)g.A + (size_t)nxt.pm * tstepA : cA; const char* nB = has_next ? (const char*)g.Bt + (size_t)nxt.pn * tstepB : cB;
        for (int t = 0; t < nt; t += 2) {
            const bool last = (t == nt - 2);
            const char* a1 = cA + (size_t)(t + 1) * kstep;
            const char* a2 = last ? nA : cA + (size_t)(t + 2) * kstep; const char* b2 = last ? nB : cB + (size_t)(t + 2) * kstep;
            const char* a3 = a2 + kstep; const char* b3 = b2 + kstep;
            if (last && has_next) S.a_ready(nxt);
            if constexpr (SP2) {
            PG8_LDB(B0, 0, 0); PG8_LDB(B1, 0, 1); PG8_SCHED; PG8_LDA(At, 0, 0); PG8_STAGE(PG8_SA(1, 1), a1 + hstepA, offA);
            PG8_WAIT_V(8); PG8_WAIT_L(0); PG8_BAR; PG8_MMA(0, 0, At, B0); PG8_MMA(0, 1, At, B1); PG8_BAR; PG8_SCHED;
            PG8_LDA(At, 0, 1); PG8_STAGE(PG8_SB(0, 0), b2, offB); PG8_STAGE(PG8_SB(0, 1), b2 + hstepB, offB); PG8_STAGE(PG8_SA(0, 0), a2, offA);
            PG8_WAIT_V(8); PG8_WAIT_L(0); PG8_BAR; PG8_MMA(1, 0, At, B0); PG8_MMA(1, 1, At, B1); PG8_BAR; PG8_SCHED;
            PG8_LDB(B0, 1, 0); PG8_LDB(B1, 1, 1); PG8_SCHED; PG8_LDA(At, 1, 0); PG8_STAGE(PG8_SA(0, 1), a2 + hstepA, offA);
            PG8_WAIT_V(8); PG8_WAIT_L(0); PG8_BAR; PG8_MMA(0, 0, At, B0); PG8_MMA(0, 1, At, B1); PG8_BAR; PG8_SCHED;
            PG8_LDA(At, 1, 1); PG8_STAGE(PG8_SB(1, 0), b3, offB); PG8_STAGE(PG8_SB(1, 1), b3 + hstepB, offB); PG8_STAGE(PG8_SA(1, 0), a3, offA);
            PG8_WAIT_V(8); PG8_WAIT_L(0); PG8_BAR; PG8_MMA(1, 0, At, B0); PG8_MMA(1, 1, At, B1); PG8_BAR; PG8_SCHED;
            } else {
            PG8_LDB(B0, 0, 0); PG8_SCHED; PG8_LDA(At, 0, 0); PG8_STAGE(PG8_SA(1, 1), a1 + hstepA, offA);
            PG8_WAIT_L(8); PG8_BAR; PG8_WAIT_L(0); PG8_MMA(0, 0, At, B0); PG8_BAR; PG8_SCHED;
            PG8_LDB(B1, 0, 1); PG8_STAGE(PG8_SB(0, 0), b2, offB);
            PG8_BAR; PG8_WAIT_L(0); PG8_MMA(0, 1, At, B1); PG8_BAR;
            PG8_LDA(At, 0, 1); PG8_STAGE(PG8_SA(0, 0), a2, offA);
            PG8_BAR; PG8_WAIT_L(0); PG8_MMA(1, 0, At, B0); PG8_BAR; PG8_SCHED;
            PG8_STAGE(PG8_SB(0, 1), b2 + hstepB, offB);
            PG8_WAIT_V(6); PG8_BAR; PG8_MMA(1, 1, At, B1); PG8_BAR;
            PG8_LDB(B0, 1, 0); PG8_SCHED; PG8_LDA(At, 1, 0); PG8_STAGE(PG8_SA(0, 1), a2 + hstepA, offA);
            PG8_WAIT_L(8); PG8_BAR; PG8_WAIT_L(0); PG8_MMA(0, 0, At, B0); PG8_BAR; PG8_SCHED;
            PG8_LDB(B1, 1, 1); PG8_STAGE(PG8_SB(1, 0), b3, offB);
            PG8_BAR; PG8_WAIT_L(0); PG8_MMA(0, 1, At, B1); PG8_BAR;
            PG8_LDA(At, 1, 1); PG8_STAGE(PG8_SA(1, 0), a3, offA);
            PG8_BAR; PG8_WAIT_L(0); PG8_MMA(1, 0, At, B0); PG8_BAR; PG8_SCHED;
            PG8_STAGE(PG8_SB(1, 1), b3 + hstepB, offB);
            PG8_WAIT_V(6); PG8_BAR; PG8_MMA(1, 1, At, B1); PG8_BAR;
            }
        }
        if constexpr (ALIGN_EPI) { if (wr == 0) PG8_BAR; }
        if constexpr (!Epi::AFTER_DRAIN) { E(acc, cur, wr, wc, fr, fq); S.done(cur); }
        if (!has_next) break;
#pragma unroll
        for (int a = 0; a < 2; ++a)
#pragma unroll
            for (int b = 0; b < 2; ++b)
#pragma unroll
                for (int m = 0; m < 4; ++m)
#pragma unroll
                    for (int n = 0; n < 2; ++n) acc[a][b][m][n] = (f32x4){0.f, 0.f, 0.f, 0.f};
        cur = nxt; cA = nA; cB = nB; ++ui;
        if constexpr (ALIGN_EPI) { if (wr == 1) PG8_BAR; }
    }
    PG8_WAIT_V(0);
    if constexpr (!ALIGN_EPI) { if (wr == 0) PG8_BAR; }
    PG8_BAR;
    if constexpr (Epi::AFTER_DRAIN) { E.fused(acc, cur, wr, wc, fr, fq, lds, wid, lane); S.done(cur); }
#undef PG8_SA
#undef PG8_SB
#undef PG8_STAGE
#undef PG8_LDA
#undef PG8_LDB
#undef PG8_MMA
#undef PG8_WAIT_V
#undef PG8_WAIT_L
#undef PG8_BAR
#undef PG8_SCHED
}
}

#define LAS __attribute__((address_space(3)))
typedef unsigned short bf16_t;
typedef short bf16x8 __attribute__((ext_vector_type(8)));
typedef float f32x4 __attribute__((ext_vector_type(4)));
typedef unsigned u32x4 __attribute__((ext_vector_type(4)));
typedef unsigned u32x2 __attribute__((ext_vector_type(2)));

constexpr int NTOK = 16384, DM = 1024, SEQ = 2048;
constexpr int A_IN = 5120, B_IN = 3072, OUT_K = 1536;
constexpr float EPS = 1e-6f;
constexpr float LOG2E = 1.4426950408889634f;
constexpr size_t MiB = 1u << 20;
constexpr size_t WS_WA_IN = 1 * MiB, WS_WA_OUT = 21 * MiB, WS_MKV = 27 * MiB, WS_XN = 43 * MiB, WS_Z = 75 * MiB, WS_END = 235 * MiB;
constexpr size_t ZT_WMEM = 0, ZT_MEMHAT = 8 * MiB;
constexpr size_t ZB_WIN0 = 96 * MiB, ZB_WIN1 = 103 * MiB, ZB_WOUT = 109 * MiB, ZB_COS = 115 * MiB, ZB_SIN = 117 * MiB, ZB_KV = 119 * MiB;
constexpr int LDS_BYTES = 147456;

__device__ __forceinline__ float bf2f(unsigned short u) { return __uint_as_float((unsigned)u << 16); }
__device__ __forceinline__ unsigned pk2(float lo, float hi) { return pg8::cvt_pk_bf16(lo, hi); }
__device__ __forceinline__ float wave_sum(float v) {
#pragma unroll
    for (int o = 1; o < 64; o <<= 1) v += __shfl_xor(v, o);
    return v;
}
__device__ __forceinline__ float fast_exp2(float x) { return __builtin_amdgcn_exp2f(x); }
__device__ __forceinline__ float fast_rcp(float x) { return __builtin_amdgcn_rcpf(x); }
__device__ __forceinline__ float silu_f(float x) { return x * fast_rcp(1.0f + fast_exp2(-x * LOG2E)); }
__device__ __forceinline__ f32x4 mfma16(bf16x8 a, bf16x8 b, f32x4 c) { return __builtin_amdgcn_mfma_f32_16x16x32_bf16(a, b, c, 0, 0, 0); }

struct EpiGen {
    static constexpr bool PERM = true, AFTER_DRAIN = false;
    bf16_t* O; int ldc; int mode; unsigned char* wsz;
    __device__ __forceinline__ void operator()(const pg8::f32x4 (&acc)[2][2][4][2], const pg8::Unit& u, int wr, int wc, int fr, int fq) const {
        const int row0 = u.pm * 256 + wr * 64 + fr;
        int colt = u.pn * 256; bf16_t* base = O; int ld = ldc; bool rope = false;
        if (mode == 1) { if (u.pn < 4) rope = true; else if (u.pn >= 12) { base = (bf16_t*)(wsz + ZB_KV); ld = 512; colt = (u.pn - 12) * 256; rope = (u.pn == 12); } }
        const int col0 = colt + wc * 32 + 8 * fq;
        if (rope) {
            const int i0 = (col0 & 63) >> 1; const float* cosT = (const float*)(wsz + ZB_COS); const float* sinT = (const float*)(wsz + ZB_SIN);
#pragma unroll
            for (int ai = 0; ai < 2; ++ai)
#pragma unroll
                for (int m = 0; m < 4; ++m) {
                    const int row = row0 + ai * 128 + m * 16;
                    const f32x4 cs = *(const f32x4*)(cosT + (size_t)row * 32 + i0), sn = *(const f32x4*)(sinT + (size_t)row * 32 + i0);
                    bf16_t* rowp = base + (size_t)row * ld + col0;
#pragma unroll
                    for (int bj = 0; bj < 2; ++bj) {
                        const f32x4 v0 = acc[ai][bj][m][0], v1 = acc[ai][bj][m][1];
                        u32x4 w;
                        w.x = pk2(v0[0] * cs[0] - v0[1] * sn[0], v0[1] * cs[0] + v0[0] * sn[0]);
                        w.y = pk2(v0[2] * cs[1] - v0[3] * sn[1], v0[3] * cs[1] + v0[2] * sn[1]);
                        w.z = pk2(v1[0] * cs[2] - v1[1] * sn[2], v1[1] * cs[2] + v1[0] * sn[2]);
                        w.w = pk2(v1[2] * cs[3] - v1[3] * sn[3], v1[3] * cs[3] + v1[2] * sn[3]);
                        *(u32x4*)(rowp + bj * 128) = w;
                    }
                }
        } else {
#pragma unroll
            for (int ai = 0; ai < 2; ++ai)
#pragma unroll
                for (int m = 0; m < 4; ++m) {
                    bf16_t* rowp = base + (size_t)(row0 + ai * 128 + m * 16) * ld + col0;
#pragma unroll
                    for (int bj = 0; bj < 2; ++bj) {
                        const f32x4 v0 = acc[ai][bj][m][0], v1 = acc[ai][bj][m][1];
                        u32x4 w; w.x = pk2(v0[0], v0[1]); w.y = pk2(v0[2], v0[3]); w.z = pk2(v1[0], v1[1]); w.w = pk2(v1[2], v1[3]);
                        *(u32x4*)(rowp + bj * 128) = w;
                    }
                }
        }
    }
};

__device__ __forceinline__ void transpose_item(const float* W, int K, int N, bf16_t* WT, int row_off, const float* gain, int perm_lim, LAS float* scr, int item, int lane) {
    const int nblk = N / 32, kb = item / nblk, nb = item % nblk, k0 = 64 * kb, n0 = 32 * nb;
#pragma unroll 8
    for (int i = 0; i < 32; ++i) { const int kk = 2 * i + (lane >> 5); const float gk = gain ? gain[k0 + kk] : 1.0f; scr[kk * 33 + (lane & 31)] = W[(size_t)(k0 + kk) * N + n0 + (lane & 31)] * gk; }
    asm volatile("s_waitcnt lgkmcnt(0)" ::: "memory");
    const int c = lane & 7;
#pragma unroll
    for (int j = 0; j < 4; ++j) {
        const int n = (lane >> 3) + 8 * j; const LAS float* s = scr + (8 * c) * 33 + n;
        u32x4 o; o.x = pk2(s[0 * 33], s[1 * 33]); o.y = pk2(s[2 * 33], s[3 * 33]); o.z = pk2(s[4 * 33], s[5 * 33]); o.w = pk2(s[6 * 33], s[7 * 33]);
        const int ng = n0 + n; const int dst = (ng < perm_lim) ? ((ng & ~63) + 2 * (ng & 31) + ((ng >> 5) & 1)) : ng;
        *(u32x4*)(WT + (size_t)(row_off + dst) * K + k0 + 8 * c) = o;
    }
    asm volatile("s_waitcnt lgkmcnt(0)" ::: "memory");
}
__device__ __forceinline__ void xhat_row(const float* xrow, bf16_t* orow, int lane) {
    const f32x4* xr = (const f32x4*)xrow + lane; f32x4 v[4]; float s = 0.f;
#pragma unroll
    for (int j = 0; j < 4; ++j) { v[j] = xr[64 * j]; s += (v[j][0] * v[j][0] + v[j][1] * v[j][1]) + (v[j][2] * v[j][2] + v[j][3] * v[j][3]); }
    const float r = 1.0f / sqrtf(wave_sum(s) * (1.0f / 1024.0f) + EPS);
    u32x2* o = (u32x2*)orow + lane;
#pragma unroll
    for (int j = 0; j < 4; ++j) { u32x2 w; w.x = pk2(v[j][0] * r, v[j][1] * r); w.y = pk2(v[j][2] * r, v[j][3] * r); o[64 * j] = w; }
}
__device__ __forceinline__ void norm_row(const bf16_t* yrow, const float* hin, const float* gpost, float* hout, bf16_t* xnrow, bool write_xn, int lane) {
    const u32x2* yr = (const u32x2*)yrow + lane; f32x4 y[4]; float s = 0.f;
#pragma unroll
    for (int j = 0; j < 4; ++j) { const u32x2 w = yr[64 * j]; y[j][0] = __uint_as_float(w.x << 16); y[j][1] = __uint_as_float(w.x & 0xffff0000u); y[j][2] = __uint_as_float(w.y << 16); y[j][3] = __uint_as_float(w.y & 0xffff0000u);
        s += (y[j][0] * y[j][0] + y[j][1] * y[j][1]) + (y[j][2] * y[j][2] + y[j][3] * y[j][3]); }
    const float r = 1.0f / sqrtf(wave_sum(s) * (1.0f / 1024.0f) + EPS);
    const f32x4* hr = (const f32x4*)hin + lane; const f32x4* gr = (const f32x4*)gpost + lane; f32x4* ho = (f32x4*)hout + lane; float s2 = 0.f;
#pragma unroll
    for (int j = 0; j < 4; ++j) { const f32x4 h = hr[64 * j] + y[j] * r * gr[64 * j]; y[j] = h; ho[64 * j] = h; s2 += (h[0] * h[0] + h[1] * h[1]) + (h[2] * h[2] + h[3] * h[3]); }
    if (write_xn) {
        const float r2 = 1.0f / sqrtf(wave_sum(s2) * (1.0f / 1024.0f) + EPS);
        u32x2* o = (u32x2*)xnrow + lane;
#pragma unroll
        for (int j = 0; j < 4; ++j) { u32x2 w; w.x = pk2(y[j][0] * r2, y[j][1] * r2); w.y = pk2(y[j][2] * r2, y[j][3] * r2); o[64 * j] = w; }
    }
}

template <int D, int NK, bool SWA>
__device__ __forceinline__ void attn_rowtile2(const LAS unsigned char* Kl, const LAS unsigned char* VT, const bf16_t* qptr, const bf16_t* gptr, bf16_t* optr, float sc2, float sink2, int irow, bool first_blk, int c, int g) {
    constexpr int KSTR = (D + 8) * 2, VSTR = (NK + 8) * 2, NKT = NK / 16, NKK = D / 32, NDT = D / 16, NK2 = NK / 32;
    bf16x8 qf[NKK];
#pragma unroll
    for (int kk = 0; kk < NKK; ++kk) qf[kk] = *(const bf16x8*)(qptr + kk * 32 + g * 8);
    f32x4 st[NKT];
#pragma unroll
    for (int kt = 0; kt < NKT; ++kt) {
        f32x4 a = {0.f, 0.f, 0.f, 0.f};
#pragma unroll
        for (int kk = 0; kk < NKK; ++kk) { const bf16x8 kf = *(const LAS bf16x8*)(Kl + (16 * kt + c) * KSTR + kk * 64 + g * 16); a = mfma16(kf, qf[kk], a); }
        st[kt] = a;
    }
    float m = -INFINITY;
#pragma unroll
    for (int kt = 0; kt < NKT; ++kt)
#pragma unroll
        for (int r = 0; r < 4; ++r) {
            float x = st[kt][r] * sc2;
            if (SWA) { const int j = 16 * kt + 4 * g + r; const bool ok = (j > irow) && (j <= irow + 128) && (!first_blk || j >= 128); x = ok ? x : -INFINITY; }
            st[kt][r] = x; m = fmaxf(m, x);
        }
    m = fmaxf(m, __shfl_xor(m, 16)); m = fmaxf(m, __shfl_xor(m, 32));
    if (SWA) m = fmaxf(m, sink2);
    float l = 0.f;
#pragma unroll
    for (int kt = 0; kt < NKT; ++kt)
#pragma unroll
        for (int r = 0; r < 4; ++r) { const float p = fast_exp2(st[kt][r] - m); st[kt][r] = p; l += p; }
    l += __shfl_xor(l, 16); l += __shfl_xor(l, 32);
    if (SWA) l += fast_exp2(sink2 - m);
    const float inv = 1.0f / l;
    bf16x8 pf[NK2];
#pragma unroll
    for (int k2 = 0; k2 < NK2; ++k2) {
        u32x4 w; w.x = pk2(st[2 * k2][0], st[2 * k2][1]); w.y = pk2(st[2 * k2][2], st[2 * k2][3]); w.z = pk2(st[2 * k2 + 1][0], st[2 * k2 + 1][1]); w.w = pk2(st[2 * k2 + 1][2], st[2 * k2 + 1][3]);
        pf[k2] = __builtin_bit_cast(bf16x8, w);
    }
#pragma unroll
    for (int dt = 0; dt < NDT; ++dt) {
        f32x4 a = {0.f, 0.f, 0.f, 0.f};
#pragma unroll
        for (int k2 = 0; k2 < NK2; ++k2) {
            const LAS unsigned char* vp = VT + (16 * dt + c) * VSTR + (32 * k2 + 4 * g) * 2;
            const u32x2 lo = *(const LAS u32x2*)vp, hi = *(const LAS u32x2*)(vp + 32);
            u32x4 w; w.x = lo.x; w.y = lo.y; w.z = hi.x; w.w = hi.y;
            a = mfma16(__builtin_bit_cast(bf16x8, w), pf[k2], a);
        }
        const u32x2 gw = *(const u32x2*)(gptr + 16 * dt + 4 * g);
        const float g0 = __uint_as_float(gw.x << 16), g1 = __uint_as_float(gw.x & 0xffff0000u), g2 = __uint_as_float(gw.y << 16), g3 = __uint_as_float(gw.y & 0xffff0000u);
        u32x2 o; o.x = pk2(a[0] * inv * silu_f(g0), a[1] * inv * silu_f(g1)); o.y = pk2(a[2] * inv * silu_f(g2), a[3] * inv * silu_f(g3));
        *(u32x2*)(optr + 16 * dt + 4 * g) = o;
    }
}

__device__ __forceinline__ void vt_scatter(LAS unsigned char* vt_base, int vstr, u32x4 v) {
    LAS unsigned short* p = (LAS unsigned short*)vt_base; const int s = vstr >> 1;
    p[0 * s] = (unsigned short)(v.x & 0xffffu); p[1 * s] = (unsigned short)(v.x >> 16); p[2 * s] = (unsigned short)(v.y & 0xffffu); p[3 * s] = (unsigned short)(v.y >> 16);
    p[4 * s] = (unsigned short)(v.z & 0xffffu); p[5 * s] = (unsigned short)(v.z >> 16); p[6 * s] = (unsigned short)(v.w & 0xffffu); p[7 * s] = (unsigned short)(v.w >> 16);
}
__device__ __forceinline__ void mem_unit(LAS unsigned char* lds, int u, int l, const bf16_t* MKV, bf16_t* Z, int ldz, int qcol, int gcol, int tid) {
    constexpr int D = 128, NK = 256, KSTR = (D + 8) * 2, VSTR = (NK + 8) * 2;
    LAS unsigned char* Kl = lds; LAS unsigned char* VT = lds + NK * KSTR;
    const int tile = u >> 2, hm = u & 3, b = tile >> 3;
    const bf16_t* kv = MKV + (size_t)(b * 256) * 4096 + l * 1024 + hm * 128;
#pragma unroll 4
    for (int i = 0; i < 8; ++i) {
        const int p = tid + 512 * i, key = p >> 4, c8 = p & 15;
        const u32x4 kq = *(const u32x4*)(kv + (size_t)key * 4096 + c8 * 8);
        const u32x4 vq = *(const u32x4*)(kv + (size_t)key * 4096 + 512 + c8 * 8);
        *(LAS u32x4*)(Kl + key * KSTR + c8 * 16) = kq;
        vt_scatter(VT + (c8 * 8) * VSTR + key * 2, VSTR, vq);
    }
    __syncthreads();
    const int w = tid >> 6, lane = tid & 63, c = lane & 15, g = lane >> 4;
    const float sc2 = 0.08838834764831845f * LOG2E;
#pragma unroll 1
    for (int rt = 0; rt < 2; ++rt) {
        const int tok = tile * 256 + w * 32 + rt * 16 + c;
        bf16_t* row = Z + (size_t)tok * ldz;
        attn_rowtile2<D, NK, false>(Kl, VT, row + qcol + hm * 128, row + gcol + hm * 128, row + qcol + hm * 128, sc2, 0.f, 0, false, c, g);
    }
    __syncthreads();
}
__device__ __forceinline__ void swa_unit(LAS unsigned char* lds, int u, const bf16_t* KV, bf16_t* Z, const float* sinks, int tid) {
    constexpr int D = 64, NK = 256, KSTR = (D + 8) * 2, VSTR = (NK + 8) * 2;
    LAS unsigned char* Kl = lds; LAS unsigned char* VT = lds + NK * KSTR;
    const int nb = u & 15, kvh = (u >> 4) & 3, b = u >> 6;
#pragma unroll
    for (int i = 0; i < 4; ++i) {
        const int p = tid + 512 * i, key = p >> 3, c8 = p & 7, pos = (nb - 1) * 128 + key;
        u32x4 kq = {0u, 0u, 0u, 0u}, vq = {0u, 0u, 0u, 0u};
        if (pos >= 0) { const bf16_t* src = KV + (size_t)(b * SEQ + pos) * 512 + kvh * 64 + c8 * 8; kq = *(const u32x4*)src; vq = *(const u32x4*)(src + 256); }
        *(LAS u32x4*)(Kl + key * KSTR + c8 * 16) = kq;
        vt_scatter(VT + (c8 * 8) * VSTR + key * 2, VSTR, vq);
    }
    __syncthreads();
    const int w = tid >> 6, lane = tid & 63, c = lane & 15, g = lane >> 4;
    const int hq = kvh * 4 + (w >> 1);
    const float sink2 = sinks[hq] * LOG2E;
#pragma unroll 1
    for (int rt = 0; rt < 4; ++rt) {
        const int i = (w & 1) * 64 + rt * 16 + c;
        bf16_t* row = Z + (size_t)(b * SEQ + nb * 128 + i) * B_IN;
        attn_rowtile2<D, NK, true>(Kl, VT, row + hq * 64, row + 1024 + hq * 64, row + 1024 + hq * 64, 0.125f * LOG2E, sink2, i, nb == 0, c, g);
    }
    __syncthreads();
}
__device__ __forceinline__ void hgrn_unit(LAS unsigned char* lds, bf16_t* Zb, int h, int layer, const float* lblog, const float* gnorm, int tid) {
    constexpr int L_RAWQ = 0, L_RAWF = 16384, L_OBUF = 0, L_RAWG = 32768, L_VT = 49152, L_QH = 67584, L_QT = 84992, L_KT = 102400, L_KHT = 119808, L_P15 = 144384;
    constexpr int VTS = 144, QS = 272;
    const int lane = tid & 63, w = tid >> 6, c = lane & 15, g = lane >> 4;
    const int kc = tid & 127, blk = tid >> 7;
    float lbv;
    { const int chn = h * 128 + kc; const float a0 = lblog[chn], a1 = lblog[1024 + chn], a2 = lblog[2048 + chn]; const float mx = fmaxf(a0, fmaxf(a1, a2));
      const float e0 = expf(a0 - mx), e1 = expf(a1 - mx), e2 = expf(a2 - mx); lbv = (layer == 0 ? e0 : e0 + e1) / (e0 + e1 + e2); }
    const float oml = 1.0f - lbv;
    const int t4 = tid >> 3, vs = (tid & 7) * 16;
    f32x4 gn[4];
#pragma unroll
    for (int i = 0; i < 4; ++i) gn[i] = *(const f32x4*)(gnorm + vs + 4 * i);
    f32x4 S[8];
#pragma unroll
    for (int i = 0; i < 8; ++i) S[i] = (f32x4){0.f, 0.f, 0.f, 0.f};
    u32x4 rq[2], rf[2], rv[2], rg[2];
    const bf16_t* zh = Zb + h * 128;
#pragma unroll
    for (int i = 0; i < 2; ++i) { const int p = tid + 512 * i, row = p >> 4, c8 = p & 15; const bf16_t* src = zh + (size_t)row * A_IN + c8 * 8;
        rq[i] = *(const u32x4*)src; rf[i] = *(const u32x4*)(src + 1024); rv[i] = *(const u32x4*)(src + 2048); rg[i] = *(const u32x4*)(src + 3072); }
#pragma unroll 1
    for (int ch = 0; ch < 32; ++ch) {
#pragma unroll
        for (int i = 0; i < 2; ++i) { const int p = tid + 512 * i, row = p >> 4, c8 = p & 15;
            *(LAS u32x4*)(lds + L_RAWQ + row * 256 + c8 * 16) = rq[i]; *(LAS u32x4*)(lds + L_RAWF + row * 256 + c8 * 16) = rf[i]; *(LAS u32x4*)(lds + L_RAWG + row * 256 + c8 * 16) = rg[i];
            vt_scatter(lds + L_VT + (c8 * 8) * VTS + row * 2, VTS, rv[i]); }
        if (ch + 1 < 32) {
#pragma unroll
            for (int i = 0; i < 2; ++i) { const int p = tid + 512 * i, row = p >> 4, c8 = p & 15; const bf16_t* src = zh + (size_t)((ch + 1) * 64 + row) * A_IN + c8 * 8;
                rq[i] = *(const u32x4*)src; rf[i] = *(const u32x4*)(src + 1024); rv[i] = *(const u32x4*)(src + 2048); rg[i] = *(const u32x4*)(src + 3072); }
        }
        __syncthreads();
        {
            float P[16], kk[16], qs[16]; float run = 1.0f;
            const LAS unsigned short* rF = (const LAS unsigned short*)(lds + L_RAWF) + (16 * blk) * 128 + kc;
            const LAS unsigned short* rQ = (const LAS unsigned short*)(lds + L_RAWQ) + (16 * blk) * 128 + kc;
#pragma unroll
            for (int s = 0; s < 16; ++s) {
                float fp = bf2f(rF[s * 128]); const float qp = bf2f(rQ[s * 128]);
                fp = fminf(fmaxf(fp, -30.f), 30.f);
                const float e = fast_exp2(-fp * LOG2E), sg = fast_rcp(1.0f + e);
                const float f = lbv + oml * sg; run *= f; P[s] = fmaxf(run, 1e-30f); kk[s] = oml * (e * sg);
                qs[s] = silu_f(qp);
            }
            const float P7 = P[7], P15 = P[15], iP7 = fast_rcp(P7), r157 = P15 * iP7;
            LAS unsigned short* qh = (LAS unsigned short*)(lds + L_QH) + (16 * blk) * (QS / 2) + kc;
            LAS unsigned short* qt = (LAS unsigned short*)(lds + L_QT) + (16 * blk) * (QS / 2) + kc;
            LAS unsigned short* kt = (LAS unsigned short*)(lds + L_KT) + (16 * blk) * (QS / 2) + kc;
            float khv[16];
#pragma unroll
            for (int s = 0; s < 16; ++s) {
                const float qhv = qs[s] * P[s], qtv = qhv * iP7, ktv = kk[s] * P7 * fast_rcp(P[s]);
                khv[s] = ktv * r157;
                qh[s * (QS / 2)] = (unsigned short)pk2(qhv, qhv); qt[s * (QS / 2)] = (unsigned short)pk2(qtv, qtv); kt[s * (QS / 2)] = (unsigned short)pk2(ktv, ktv);
            }
            u32x4 k0, k1; k0.x = pk2(khv[0], khv[1]); k0.y = pk2(khv[2], khv[3]); k0.z = pk2(khv[4], khv[5]); k0.w = pk2(khv[6], khv[7]);
            k1.x = pk2(khv[8], khv[9]); k1.y = pk2(khv[10], khv[11]); k1.z = pk2(khv[12], khv[13]); k1.w = pk2(khv[14], khv[15]);
            *(LAS u32x4*)(lds + L_KHT + (blk * 128 + kc) * 48) = k0; *(LAS u32x4*)(lds + L_KHT + (blk * 128 + kc) * 48 + 16) = k1;
            *(LAS float*)(lds + L_P15 + (blk * 128 + kc) * 4) = P15;
        }
        __syncthreads();
#pragma unroll 1
        for (int b2 = 0; b2 < 4; ++b2) {
            const int tb = 16 * b2;
            f32x4 aS = {0.f, 0.f, 0.f, 0.f};
#pragma unroll
            for (int k4 = 0; k4 < 4; ++k4) {
                const bf16x8 a = *(const LAS bf16x8*)(lds + L_KT + (tb + c) * QS + k4 * 64 + g * 16);
                const bf16x8 b = *(const LAS bf16x8*)(lds + L_QT + (tb + c) * QS + k4 * 64 + g * 16);
                aS = mfma16(a, b, aS);
            }
#pragma unroll
            for (int r = 0; r < 4; ++r) if (4 * g + r > c) aS[r] = 0.f;
            u32x4 pw; pw.x = pk2(aS[0], aS[1]); pw.y = pk2(aS[2], aS[3]); pw.z = 0u; pw.w = 0u;
            const u32x2 vv = *(const LAS u32x2*)(lds + L_VT + (16 * w + c) * VTS + (tb + 4 * g) * 2);
            u32x4 vw; vw.x = vv.x; vw.y = vv.y; vw.z = 0u; vw.w = 0u;
            f32x4 aO = mfma16(__builtin_bit_cast(bf16x8, pw), __builtin_bit_cast(bf16x8, vw), (f32x4){0.f, 0.f, 0.f, 0.f});
#pragma unroll
            for (int k4 = 0; k4 < 4; ++k4) {
                const LAS unsigned char* qp = lds + L_QH + (tb + c) * QS + (32 * k4 + 4 * g) * 2;
                const u32x2 q0 = *(const LAS u32x2*)qp, q1 = *(const LAS u32x2*)(qp + 32);
                u32x4 qa; qa.x = q0.x; qa.y = q0.y; qa.z = q1.x; qa.w = q1.y;
                u32x4 sb; sb.x = pk2(S[2 * k4][0], S[2 * k4][1]); sb.y = pk2(S[2 * k4][2], S[2 * k4][3]); sb.z = pk2(S[2 * k4 + 1][0], S[2 * k4 + 1][1]); sb.w = pk2(S[2 * k4 + 1][2], S[2 * k4 + 1][3]);
                aO = mfma16(__builtin_bit_cast(bf16x8, qa), __builtin_bit_cast(bf16x8, sb), aO);
            }
#pragma unroll
            for (int r = 0; r < 4; ++r) *(LAS float*)(lds + L_OBUF + ((tb + 4 * g + r) * 128 + 16 * w + c) * 4) = aO[r];
            u32x4 vb = {0u, 0u, 0u, 0u};
            if (g < 2) vb = *(const LAS u32x4*)(lds + L_VT + (16 * w + c) * VTS + (tb + 8 * g) * 2);
#pragma unroll
            for (int kt = 0; kt < 8; ++kt) {
                const f32x4 p = *(const LAS f32x4*)(lds + L_P15 + (b2 * 128 + 16 * kt + 4 * g) * 4);
                u32x4 ka = {0u, 0u, 0u, 0u};
                if (g < 2) ka = *(const LAS u32x4*)(lds + L_KHT + (b2 * 128 + 16 * kt + c) * 48 + g * 16);
                S[kt] = mfma16(__builtin_bit_cast(bf16x8, ka), __builtin_bit_cast(bf16x8, vb), S[kt] * p);
            }
        }
        __syncthreads();
        {
            f32x4 o[4]; float ss = 0.f;
#pragma unroll
            for (int i = 0; i < 4; ++i) { o[i] = *(const LAS f32x4*)(lds + L_OBUF + (t4 * 128 + vs + 4 * i) * 4); ss += (o[i][0] * o[i][0] + o[i][1] * o[i][1]) + (o[i][2] * o[i][2] + o[i][3] * o[i][3]); }
            ss += __shfl_xor(ss, 1); ss += __shfl_xor(ss, 2); ss += __shfl_xor(ss, 4);
            const float r = 1.0f / sqrtf(ss * (1.0f / 128.0f) + EPS);
            const u32x4 ga = *(const LAS u32x4*)(lds + L_RAWG + t4 * 256 + vs * 2), gb = *(const LAS u32x4*)(lds + L_RAWG + t4 * 256 + vs * 2 + 16);
            const unsigned gwv[8] = {ga.x, ga.y, ga.z, ga.w, gb.x, gb.y, gb.z, gb.w};
            unsigned ow[8];
#pragma unroll
            for (int i = 0; i < 8; ++i) {
                const float g0 = __uint_as_float(gwv[i] << 16), g1 = __uint_as_float(gwv[i] & 0xffff0000u);
                const float o0 = o[i >> 1][(i & 1) * 2], o1 = o[i >> 1][(i & 1) * 2 + 1];
                const float n0 = gn[i >> 1][(i & 1) * 2], n1 = gn[i >> 1][(i & 1) * 2 + 1];
                ow[i] = pk2(o0 * r * n0 * silu_f(g0), o1 * r * n1 * silu_f(g1));
            }
            bf16_t* dst = Zb + (size_t)(ch * 64 + t4) * A_IN + 3072 + h * 128 + vs;
            u32x4 w0, w1; w0.x = ow[0]; w0.y = ow[1]; w0.z = ow[2]; w0.w = ow[3]; w1.x = ow[4]; w1.y = ow[5]; w1.z = ow[6]; w1.w = ow[7];
            *(u32x4*)dst = w0; *(u32x4*)(dst + 8) = w1;
        }
        __syncthreads();
    }
}

struct Args { const float* in[16]; float* out; unsigned char* ws; int ph_lo, ph_hi; };
constexpr int N_PHASES = 18;

__global__ void __launch_bounds__(512, 2) fwd_kernel(Args a) {
    extern __shared__ __attribute__((aligned(16))) unsigned char lds_raw[];
    LAS unsigned char* lds = (LAS unsigned char*)lds_raw;
    cg::grid_group grid = cg::this_grid();
    const int G = gridDim.x, bx = blockIdx.x;
    unsigned char* ws = a.ws;
    bf16_t* Z = (bf16_t*)(ws + WS_Z); bf16_t* XN = (bf16_t*)(ws + WS_XN); bf16_t* MKV = (bf16_t*)(ws + WS_MKV);

#pragma unroll 1
    for (int ph = a.ph_lo; ph < a.ph_hi; ++ph) {
        int tid = threadIdx.x; asm volatile("" : "+v"(tid));
        const int lane = tid & 63, wave = __builtin_amdgcn_readfirstlane(tid >> 6);
        const int gw = bx * 8 + wave, NGW = G * 8;
        LAS float* scr = (LAS float*)(lds + wave * 16384);
        const int l = (ph - 2) >> 2, sub = (ph - 2) & 3;
        const bool is_gemm = (ph == 1) || (ph >= 2 && (sub == 0 || sub == 2));
        if (ph == 0) {
            constexpr int I_IN = 16 * 160, I_OUT = 24 * 32, I_MEM = 16 * 32, NIT = 2 * I_IN + 2 * I_OUT + 4 * I_MEM;
            for (int it = gw; it < NIT; it += NGW) {
                int r = it;
                if (r < 2 * I_IN) { const int li = r / I_IN; r -= li * I_IN;
                    transpose_item(a.in[7] + (size_t)li * DM * A_IN, DM, A_IN, (bf16_t*)(ws + WS_WA_IN) + (size_t)li * A_IN * DM, 0, a.in[3] + li * DM, 0, scr, r, lane); continue; }
                r -= 2 * I_IN;
                if (r < 2 * I_OUT) { const int li = r / I_OUT; r -= li * I_OUT;
                    transpose_item(a.in[10] + (size_t)li * OUT_K * DM, OUT_K, DM, (bf16_t*)(ws + WS_WA_OUT) + (size_t)li * DM * OUT_K, 0, nullptr, 0, scr, r, lane); continue; }
                r -= 2 * I_OUT;
                { const int li = r / I_MEM; r -= li * I_MEM;
                    transpose_item(a.in[6] + (size_t)li * DM * 1024, DM, 1024, (bf16_t*)(ws + WS_Z + ZT_WMEM), li * 1024, a.in[5] + li * DM, 0, scr, r, lane); }
            }
            for (int m = gw; m < NTOK; m += NGW) xhat_row(a.in[0] + (size_t)m * DM, XN + (size_t)m * DM, lane);
            for (int m = gw; m < 2048; m += NGW) xhat_row(a.in[1] + (size_t)m * DM, (bf16_t*)(ws + WS_Z + ZT_MEMHAT) + (size_t)m * DM, lane);
        } else if (is_gemm) {
            pg8::Gemm gm; EpiGen E; E.mode = 0; E.wsz = ws + WS_Z;
            if (ph == 1) { gm.A = (const bf16_t*)(ws + WS_Z + ZT_MEMHAT); gm.Bt = (const bf16_t*)(ws + WS_Z + ZT_WMEM); gm.M = 2048; gm.N = 4096; gm.K = 1024; gm.lda = 1024; E.O = MKV; E.ldc = 4096; }
            else if (sub == 0) {
                gm.A = XN; gm.M = NTOK; gm.K = DM; gm.lda = DM; E.O = Z;
                if (l < 2) { gm.Bt = (const bf16_t*)(ws + WS_WA_IN) + (size_t)l * A_IN * DM; gm.N = A_IN; E.ldc = A_IN; }
                else { gm.Bt = (const bf16_t*)(ws + WS_Z + (l == 2 ? ZB_WIN0 : ZB_WIN1)); gm.N = (l == 2) ? 3584 : 3072; E.ldc = B_IN; E.mode = 1; }
            } else {
                gm.M = NTOK; gm.N = DM; gm.K = OUT_K; E.O = XN; E.ldc = DM;
                if (l < 2) { gm.A = Z + 3072; gm.lda = A_IN; gm.Bt = (const bf16_t*)(ws + WS_WA_OUT) + (size_t)l * DM * OUT_K; }
                else { gm.A = Z + 1024; gm.lda = B_IN; gm.Bt = (const bf16_t*)(ws + WS_Z + ZB_WOUT) + (size_t)(l - 2) * DM * OUT_K; }
            }
            pg8::StaticOrder S; S.init(gm.M, gm.N, G, bx);
            if (gm.K == 1024) pg8::gemm_phase<EpiGen, pg8::StaticOrder, true, true, 1024, 1024>(lds, gm, S, E);
            else if (gm.lda == A_IN) pg8::gemm_phase<EpiGen, pg8::StaticOrder, true, true, 1536, A_IN>(lds, gm, S, E);
            else pg8::gemm_phase<EpiGen, pg8::StaticOrder, true, true, 1536, B_IN>(lds, gm, S, E);
        } else if (sub == 1) {
#ifndef NO_MIX
            if (l < 2) {
                if (bx < 64)
#ifndef NO_HGRN
 hgrn_unit(lds, Z + (size_t)(bx >> 3) * SEQ * A_IN, bx & 7, l, a.in[8], a.in[9] + l * 1024 + (bx & 7) * 128, tid);
#else
;
#endif
                else for (int u = bx - 64; u < 256; u += G - 64) mem_unit(lds, u, l, MKV, Z, A_IN, 4096, 4608, tid);
            } else {
                for (int u = bx; u < 768; u += G) {
                    if (u < 512) swa_unit(lds, u, (const bf16_t*)(ws + WS_Z + ZB_KV), Z, a.in[14] + (l - 2) * 16, tid);
                    else mem_unit(lds, u - 512, l, MKV, Z, B_IN, 2048, 2560, tid);
                }
            }
#endif
        } else {
            const float* hin = (l == 0) ? a.in[0] : a.out;
            for (int m = gw; m < NTOK; m += NGW) norm_row(XN + (size_t)m * DM, hin + (size_t)m * DM, a.in[4] + l * DM, a.out + (size_t)m * DM, XN + (size_t)m * DM, l < 3, lane);
            if (l == 1) {
                constexpr int I_BIN = 16 * 96, I_KV = 16 * 16, I_OUT = 24 * 32, NIT = 2 * I_BIN + I_KV + 2 * I_OUT;
                for (int it = gw; it < NIT; it += NGW) {
                    int r = it;
                    if (r < I_BIN) { transpose_item(a.in[13], DM, B_IN, (bf16_t*)(ws + WS_Z + ZB_WIN0), 0, a.in[3] + 2 * DM, 1024, scr, r, lane); continue; } r -= I_BIN;
                    if (r < I_KV) { transpose_item(a.in[12], DM, 512, (bf16_t*)(ws + WS_Z + ZB_WIN0), 3072, a.in[11], 256, scr, r, lane); continue; } r -= I_KV;
                    if (r < I_BIN) { transpose_item(a.in[13] + (size_t)DM * B_IN, DM, B_IN, (bf16_t*)(ws + WS_Z + ZB_WIN1), 0, a.in[3] + 3 * DM, 1024, scr, r, lane); continue; } r -= I_BIN;
                    { const int li = r / I_OUT; r -= li * I_OUT;
                      transpose_item(a.in[15] + (size_t)li * OUT_K * DM, OUT_K, DM, (bf16_t*)(ws + WS_Z + ZB_WOUT) + (size_t)li * DM * OUT_K, 0, nullptr, 0, scr, r, lane); }
                }
                const int* pos = (const int*)a.in[2]; float* cT = (float*)(ws + WS_Z + ZB_COS); float* sT = (float*)(ws + WS_Z + ZB_SIN);
                for (int e = bx * 512 + tid; e < NTOK * 32; e += G * 512) {
                    const int i = e & 31; const float inv_freq = exp2f(-(float)(2 * i) * (13.287712379549449f / 64.0f));
                    const float ang = (float)pos[e >> 5] * inv_freq;
                    cT[e] = cosf(ang); sT[e] = sinf(ang);
                }
            }
        }
        if (ph + 1 < a.ph_hi) grid.sync();
    }
}

#ifndef MK_PER_PHASE
#define MK_PER_PHASE 0
#endif
extern "C" void kernel_launch(void* const* d_in, const int* in_sizes, int n_in, void* d_out, int out_size, void* d_ws, size_t ws_size, hipStream_t stream) {
    static int grid = 0;
    if (grid == 0) {
        if (n_in != 16 || ws_size < WS_END) { fprintf(stderr, "kernel_launch: unexpected n_in %d / ws %zu\n", n_in, ws_size); grid = -1; return; }
        if (hipFuncSetAttribute((const void*)fwd_kernel, hipFuncAttributeMaxDynamicSharedMemorySize, LDS_BYTES) != hipSuccess) { fprintf(stderr, "hipFuncSetAttribute failed\n"); grid = -1; return; }
        int dev = 0, cus = 0, per_cu = 0;
        hipGetDevice(&dev); hipDeviceGetAttribute(&cus, hipDeviceAttributeMultiprocessorCount, dev);
        hipOccupancyMaxActiveBlocksPerMultiprocessor(&per_cu, (const void*)fwd_kernel, 512, LDS_BYTES);
        (void)hipGetLastError();
        grid = 256;
        if (per_cu < 1 || cus < 256) fprintf(stderr, "kernel_launch: occupancy %d x %d CUs < 256 workgroups\n", per_cu, cus);
    }
    if (grid < 0) return;
    Args a{};
    for (int i = 0; i < 16; ++i) a.in[i] = (const float*)d_in[i];
    a.out = (float*)d_out; a.ws = (unsigned char*)d_ws;
#if MK_PER_PHASE
    for (int ph = 0; ph < N_PHASES; ++ph) { a.ph_lo = ph; a.ph_hi = ph + 1; hipLaunchKernelGGL(fwd_kernel, dim3(grid), dim3(512), LDS_BYTES, stream, a); }
#else
    a.ph_lo = 0; a.ph_hi = N_PHASES;
    void* args[] = {&a};
    hipError_t e = hipLaunchCooperativeKernel((const void*)fwd_kernel, dim3(grid), dim3(512), args, LDS_BYTES, stream);
    if (e != hipSuccess) fprintf(stderr, "cooperative launch failed: %s\n", hipGetErrorString(e));
#endif
}
```

```cpp
#include <hip/hip_runtime.h>
#include <hip/hip_cooperative_groups.h>
#include <cstdio>
#include <cstdint>
namespace cg = cooperative_groups;
namespace pg8 {
#define PG8_LAS __attribute__((address_space(3)))
typedef unsigned short bf16_t;
typedef short bf16x8 __attribute__((ext_vector_type(8)));
typedef float f32x4 __attribute__((ext_vector_type(4)));
typedef unsigned u32x4 __attribute__((ext_vector_type(4)));
constexpr int BM = 256, BK = 64, HALF = 128, HTB = HALF * BK * 2  , STAGE_BYTES = 8 * HTB, NXCD = 8, WGM = 8;

__host__ __device__ __forceinline__ int lds_byte(int r, int c) { const int st = (r >> 4) * 2 + (c >> 5), rr = r & 15, cc = c & 31, ob = rr * 64 + cc * 2; return st * 1024 + (ob ^ (((ob >> 9) & 1) << 5)); }
__host__ __device__ __forceinline__ void stage_rc(int b, int& R, int& C) { const int st = b / 1024, sb = b % 1024, swz = sb ^ (((sb >> 9) & 1) << 5); R = (st >> 1) * 16 + swz / 64; C = (st & 1) * 32 + (swz % 64) / 2; }
__host__ __device__ __forceinline__ int perm32(int rho) { const int n = rho >> 4, i = rho & 15; return 8 * (i >> 2) + 4 * n + (i & 3); }

struct Unit { int pm, pn; };
struct Gemm { const bf16_t* A; const bf16_t* Bt; int M, N, K, lda; };

struct StaticOrder {
    int nM, nN, nwg, G, c;
    __host__ __device__ void init(int M, int N, int G_, int c_) { nM = M / BM; nN = N / BM; nwg = nM * nN; G = G_; c = c_; }
    __host__ __device__ bool next(int i, Unit& u) const {
        const long L = (long)i * G + c; if (L >= nwg) return false;
        int wgid = (int)L; { const int q = nwg / NXCD, r = nwg % NXCD, xcd = wgid % NXCD, off = wgid / NXCD; wgid = (xcd < r ? xcd * (q + 1) : r * (q + 1) + (xcd - r) * q) + off; }
        const int nig = WGM * nN, gid = wgid / nig, fm = gid * WGM, gsz = (nM - fm) < WGM ? (nM - fm) : WGM;
        u.pm = fm + ((wgid % nig) % gsz); u.pn = (wgid % nig) / gsz; return true;
    }
    __device__ __forceinline__ void a_ready(const Unit&) const {}
    __device__ __forceinline__ void done(const Unit&) const {}
};

__device__ __forceinline__ unsigned cvt_pk_bf16(float lo, float hi) { unsigned r; asm volatile("v_cvt_pk_bf16_f32 %0, %1, %2" : "=v"(r) : "v"(lo), "v"(hi)); return r; }
template <class Epi, class Sched, bool ALIGN_EPI, bool SP2, int KC, int LDAC>
__device__ __forceinline__ void gemm_phase(PG8_LAS unsigned char* lds, const Gemm g, const Sched& S, const Epi& E) {
    const int tid = threadIdx.x, wid = __builtin_amdgcn_readfirstlane(tid >> 6), lane = tid & 63, wr = wid >> 2, wc = wid & 3, fr = lane & 15, fq = lane >> 4;
    constexpr int K = KC, nt = K / BK;
    unsigned voffA, voffB;
    { int R, C; stage_rc(tid * 16, R, C); const int Rb = Epi::PERM ? ((R & ~31) + perm32(R & 31)) : R;
        voffA = (unsigned)(R * LDAC + C) * 2u; voffB = (unsigned)(Rb * K + C) * 2u; }
    constexpr size_t p2offA = (size_t)64 * LDAC * 2, p2offB = (size_t)64 * K * 2;
    const size_t kstep = (size_t)(BK * 2);
    const size_t hstepA = (size_t)HALF * LDAC * 2, hstepB = (size_t)HALF * K * 2;
    const size_t tstepA = 2 * hstepA, tstepB = 2 * hstepB;
    const unsigned ldsw = (unsigned)wid * 1024u;
    const int aoff = lds_byte(wr * 64 + fr, fq * 8), boff = lds_byte(wc * 32 + fr, fq * 8);
#define PG8_SA(b, h) (((b) * 2 + (h)) * HTB)
#define PG8_SB(b, h) ((4 + (b) * 2 + (h)) * HTB)
#define PG8_STAGE(bufoff, gbase, voff) do { _Pragma("unroll") for (int _i = 0; _i < 2; ++_i) \
        __builtin_amdgcn_global_load_lds((const unsigned*)((const char*)(gbase) + (size_t)_i * p2##voff + (v##voff)), (PG8_LAS unsigned*)(lds + (bufoff) + ldsw + _i * 8192), 16, 0, 0); } while (0)
#define PG8_LDA(dst, b, h) do { _Pragma("unroll") for (int m = 0; m < 4; ++m) _Pragma("unroll") for (int k = 0; k < 2; ++k) dst[m][k] = *(const PG8_LAS bf16x8*)(lds + PG8_SA(b, h) + aoff + m * 2048 + k * 1024); } while (0)
#define PG8_LDB(dst, b, h) do { _Pragma("unroll") for (int n = 0; n < 2; ++n) _Pragma("unroll") for (int k = 0; k < 2; ++k) dst[n][k] = *(const PG8_LAS bf16x8*)(lds + PG8_SB(b, h) + boff + n * 2048 + k * 1024); } while (0)
#define PG8_MMA(ai, bj, At, Bt) do { __builtin_amdgcn_s_setprio(1); _Pragma("unroll") for (int m = 0; m < 4; ++m) _Pragma("unroll") for (int n = 0; n < 2; ++n) _Pragma("unroll") for (int k = 0; k < 2; ++k) \
        acc[ai][bj][m][n] = __builtin_amdgcn_mfma_f32_16x16x32_bf16(Bt[n][k], At[m][k], acc[ai][bj][m][n], 0, 0, 0); __builtin_amdgcn_s_setprio(0); } while (0)
#define PG8_WAIT_V(n) asm volatile("s_waitcnt vmcnt(" #n ")" ::: "memory")
#define PG8_WAIT_L(n) asm volatile("s_waitcnt lgkmcnt(" #n ")" ::: "memory")
#define PG8_BAR __builtin_amdgcn_s_barrier()
#define PG8_SCHED __builtin_amdgcn_sched_barrier(0)
    Unit cur, nxt; int ui = 0;
    if (!S.next(0, cur)) return;
    f32x4 acc[2][2][4][2];
#pragma unroll
    for (int a = 0; a < 2; ++a)
#pragma unroll
        for (int b = 0; b < 2; ++b)
#pragma unroll
            for (int m = 0; m < 4; ++m)
#pragma unroll
                for (int n = 0; n < 2; ++n) acc[a][b][m][n] = (f32x4){0.f, 0.f, 0.f, 0.f};
    bf16x8 At[4][2], B0[2][2], B1[2][2];
    const char* cA = (const char*)g.A + (size_t)cur.pm * tstepA; const char* cB = (const char*)g.Bt + (size_t)cur.pn * tstepB;
    S.a_ready(cur);
    if constexpr (SP2) {
        PG8_STAGE(PG8_SB(0, 0), cB, offB); PG8_STAGE(PG8_SB(0, 1), cB + hstepB, offB); PG8_STAGE(PG8_SA(0, 0), cA, offA); PG8_STAGE(PG8_SA(0, 1), cA + hstepA, offA);
        if (wr == 1) PG8_BAR;
        PG8_WAIT_V(2); PG8_BAR;
        PG8_STAGE(PG8_SB(1, 0), cB + kstep, offB); PG8_STAGE(PG8_SA(1, 0), cA + kstep, offA); PG8_STAGE(PG8_SB(1, 1), cB + hstepB + kstep, offB);
        PG8_WAIT_V(6); PG8_BAR;
    } else {
        PG8_STAGE(PG8_SB(0, 0), cB, offB); PG8_STAGE(PG8_SA(0, 0), cA, offA); PG8_STAGE(PG8_SB(0, 1), cB + hstepB, offB); PG8_STAGE(PG8_SA(0, 1), cA + hstepA, offA);
        if (wr == 1) PG8_BAR;
        PG8_WAIT_V(4); PG8_BAR;
        PG8_STAGE(PG8_SB(1, 0), cB + kstep, offB); PG8_STAGE(PG8_SA(1, 0), cA + kstep, offA); PG8_STAGE(PG8_SB(1, 1), cB + hstepB + kstep, offB);
        PG8_WAIT_V(6); PG8_BAR;
    }
    for (;;) {
        const bool has_next = S.next(ui + 1, nxt);
        const char* nA = has_next ? (const char*)g.A + (size_t)nxt.pm * tstepA : cA; const char* nB = has_next ? (const char*)g.Bt + (size_t)nxt.pn * tstepB : cB;
        for (int t = 0; t < nt; t += 2) {
            const bool last = (t == nt - 2);
            const char* a1 = cA + (size_t)(t + 1) * kstep;
            const char* a2 = last ? nA : cA + (size_t)(t + 2) * kstep; const char* b2 = last ? nB : cB + (size_t)(t + 2) * kstep;
            const char* a3 = a2 + kstep; const char* b3 = b2 + kstep;
            if (last && has_next) S.a_ready(nxt);
            if constexpr (SP2) {
            PG8_LDB(B0, 0, 0); PG8_LDB(B1, 0, 1); PG8_SCHED; PG8_LDA(At, 0, 0); PG8_STAGE(PG8_SA(1, 1), a1 + hstepA, offA);
            PG8_WAIT_V(8); PG8_WAIT_L(0); PG8_BAR; PG8_MMA(0, 0, At, B0); PG8_MMA(0, 1, At, B1); PG8_BAR; PG8_SCHED;
            PG8_LDA(At, 0, 1); PG8_STAGE(PG8_SB(0, 0), b2, offB); PG8_STAGE(PG8_SB(0, 1), b2 + hstepB, offB); PG8_STAGE(PG8_SA(0, 0), a2, offA);
            PG8_WAIT_V(8); PG8_WAIT_L(0); PG8_BAR; PG8_MMA(1, 0, At, B0); PG8_MMA(1, 1, At, B1); PG8_BAR; PG8_SCHED;
            PG8_LDB(B0, 1, 0); PG8_LDB(B1, 1, 1); PG8_SCHED; PG8_LDA(At, 1, 0); PG8_STAGE(PG8_SA(0, 1), a2 + hstepA, offA);
            PG8_WAIT_V(8); PG8_WAIT_L(0); PG8_BAR; PG8_MMA(0, 0, At, B0); PG8_MMA(0, 1, At, B1); PG8_BAR; PG8_SCHED;
            PG8_LDA(At, 1, 1); PG8_STAGE(PG8_SB(1, 0), b3, offB); PG8_STAGE(PG8_SB(1, 1), b3 + hstepB, offB); PG8_STAGE(PG8_SA(1, 0), a3, offA);
            PG8_WAIT_V(8); PG8_WAIT_L(0); PG8_BAR; PG8_MMA(1, 0, At, B0); PG8_MMA(1, 1, At, B1); PG8_BAR; PG8_SCHED;
            } else {
            PG8_LDB(B0, 0, 0); PG8_SCHED; PG8_LDA(At, 0, 0); PG8_STAGE(PG8_SA(1, 1), a1 + hstepA, offA);
            PG8_WAIT_L(8); PG8_BAR; PG8_WAIT_L(0); PG8_MMA(0, 0, At, B0); PG8_BAR; PG8_SCHED;
            PG8_LDB(B1, 0, 1); PG8_STAGE(PG8_SB(0, 0), b2, offB);
            PG8_BAR; PG8_WAIT_L(0); PG8_MMA(0, 1, At, B1); PG8_BAR;
            PG8_LDA(At, 0, 1); PG8_STAGE(PG8_SA(0, 0), a2, offA);
            PG8_BAR; PG8_WAIT_L(0); PG8_MMA(1, 0, At, B0); PG8_BAR; PG8_SCHED;
            PG8_STAGE(PG8_SB(0, 1), b2 + hstepB, offB);
            PG8_WAIT_V(6); PG8_BAR; PG8_MMA(1, 1, At, B1); PG8_BAR;
            PG8_LDB(B0, 1, 0); PG8_SCHED; PG8_LDA(At, 1, 0); PG8_STAGE(PG8_SA(0, 1), a2 + hstepA, offA);
            PG8_WAIT_L(8); PG8_BAR; PG8_WAIT_L(0); PG8_MMA(0, 0, At, B0); PG8_BAR; PG8_SCHED;
            PG8_LDB(B1, 1, 1); PG8_STAGE(PG8_SB(1, 0), b3, offB);
            PG8_BAR; PG8_WAIT_L(0); PG8_MMA(0, 1, At, B1); PG8_BAR;
            PG8_LDA(At, 1, 1); PG8_STAGE(PG8_SA(1, 0), a3, offA);
            PG8_BAR; PG8_WAIT_L(0); PG8_MMA(1, 0, At, B0); PG8_BAR; PG8_SCHED;
            PG8_STAGE(PG8_SB(1, 1), b3 + hstepB, offB);
            PG8_WAIT_V(6); PG8_BAR; PG8_MMA(1, 1, At, B1); PG8_BAR;
            }
        }
        if constexpr (ALIGN_EPI) { if (wr == 0) PG8_BAR; }
        if constexpr (!Epi::AFTER_DRAIN) { E(acc, cur, wr, wc, fr, fq); S.done(cur); }
        if (!has_next) break;
#pragma unroll
        for (int a = 0; a < 2; ++a)
#pragma unroll
            for (int b = 0; b < 2; ++b)
#pragma unroll
                for (int m = 0; m < 4; ++m)
#pragma unroll
                    for (int n = 0; n < 2; ++n) acc[a][b][m][n] = (f32x4){0.f, 0.f, 0.f, 0.f};
        cur = nxt; cA = nA; cB = nB; ++ui;
        if constexpr (ALIGN_EPI) { if (wr == 1) PG8_BAR; }
    }
    PG8_WAIT_V(0);
    if constexpr (!ALIGN_EPI) { if (wr == 0) PG8_BAR; }
    PG8_BAR;
    if constexpr (Epi::AFTER_DRAIN) { E.fused(acc, cur, wr, wc, fr, fq, lds, wid, lane); S.done(cur); }
#undef PG8_SA
#undef PG8_SB
#undef PG8_STAGE
#undef PG8_LDA
#undef PG8_LDB
#undef PG8_MMA
#undef PG8_WAIT_V
#undef PG8_WAIT_L
#undef PG8_BAR
#undef PG8_SCHED
}
}

#define LAS __attribute__((address_space(3)))
typedef unsigned short bf16_t;
typedef short bf16x8 __attribute__((ext_vector_type(8)));
typedef float f32x4 __attribute__((ext_vector_type(4)));
typedef unsigned u32x4 __attribute__((ext_vector_type(4)));
typedef unsigned u32x2 __attribute__((ext_vector_type(2)));

constexpr int NTOK = 16384, DM = 1024, SEQ = 2048;
constexpr int A_IN = 5120, B_IN = 3072, OUT_K = 1536;
constexpr float EPS = 1e-6f;
constexpr float LOG2E = 1.4426950408889634f;
constexpr size_t MiB = 1u << 20;
constexpr size_t WS_WA_IN = 1 * MiB, WS_WA_OUT = 21 * MiB, WS_MKV = 27 * MiB, WS_XN = 43 * MiB, WS_Z = 75 * MiB, WS_END = 235 * MiB;
constexpr size_t ZT_WMEM = 0, ZT_MEMHAT = 8 * MiB;
constexpr size_t ZB_WIN0 = 96 * MiB, ZB_WIN1 = 103 * MiB, ZB_WOUT = 109 * MiB, ZB_COS = 115 * MiB, ZB_SIN = 117 * MiB, ZB_KV = 119 * MiB;
constexpr int LDS_BYTES = 147456;

#define XB_TMO      128
#define XB_XCNT(j)  (256  + 64 * (j))
#define XB_XSUB(j)  (1280 + 64 * (j))
#define XB_XGEN(j)  (2304 + 64 * (j))
#define XB_TOP      3328
#define XB_TOPGEN   3392
#define XCD_BAR_WORDS 3456
#define XB_SPIN_CAP (1u << 18)

__device__ __forceinline__ unsigned xb_ld(unsigned* p)              { return __hip_atomic_load(p, __ATOMIC_RELAXED, __HIP_MEMORY_SCOPE_AGENT); }
__device__ __forceinline__ unsigned xb_add(unsigned* p, unsigned v) { return __hip_atomic_fetch_add(p, v, __ATOMIC_RELAXED, __HIP_MEMORY_SCOPE_AGENT); }
__device__ __forceinline__ unsigned xb_xcc_id() { return (unsigned)__builtin_amdgcn_s_getreg((3 << 11) | 20) & 0xFu; }
#define XB_SPIN(cond, bar) do { unsigned _sp = 0; while (cond) { __builtin_amdgcn_s_sleep(1); \
    if ((++_sp & 255u) == 0u) { if (xb_ld(&(bar)[XB_TMO])) break; if (_sp > XB_SPIN_CAP) { atomicAdd(&(bar)[XB_TMO], 1u); break; } } } } while (0)

struct XcdBarrier {
    unsigned* bar; unsigned x;
    volatile LAS unsigned* st;
};

__device__ __forceinline__ XcdBarrier xcd_barrier_post(unsigned* bar, volatile LAS unsigned* st) {
    XcdBarrier b; b.bar = bar; b.x = xb_xcc_id(); b.st = st;
    if (threadIdx.x == 0) (void)xb_add(&bar[XB_XCNT(b.x)], 1u);
    return b;
}
__device__ __forceinline__ void xcd_barrier_complete(unsigned* bar, unsigned x, unsigned& nloc, unsigned& nx) {
    const unsigned G = gridDim.x * gridDim.y * gridDim.z;
    unsigned sum, cnt, mine, sp = 0u;
    for (;;) {
        sum = 0u; cnt = 0u; mine = 0u;
#pragma unroll
        for (unsigned j = 0; j < 16; ++j) { const unsigned c = xb_ld(&bar[XB_XCNT(j)]); sum += c; cnt += (c > 0u) ? 1u : 0u; mine = (j == x) ? c : mine; }
        if (sum == G) break;
        __builtin_amdgcn_s_sleep(1);
        if ((++sp & 255u) == 0u) { if (xb_ld(&bar[XB_TMO])) break; if (sp > XB_SPIN_CAP) { atomicAdd(&bar[XB_TMO], 1u); break; } }
    }
    nloc = mine > 0u ? mine : 1u; nx = cnt > 0u ? cnt : 1u;
}

__device__ __forceinline__ void xcd_barrier(const XcdBarrier& b) {
    asm volatile("s_waitcnt vmcnt(0)" ::: "memory");
    __syncthreads();
    if (threadIdx.x == 0) {
        unsigned* bar = b.bar;
        __builtin_amdgcn_s_waitcnt(0);
        unsigned nloc = b.st[0], nx = b.st[1];
        if (nloc == 0u) { xcd_barrier_complete(bar, b.x, nloc, nx); b.st[0] = nloc; b.st[1] = nx; }
        const unsigned old = xb_add(&bar[XB_XSUB(b.x)], 1u);
        const unsigned gen = old / nloc;
        if (old + 1u == (gen + 1u) * nloc) {
            __builtin_amdgcn_fence(__ATOMIC_RELEASE, "agent");
            asm volatile("s_waitcnt vmcnt(0)" ::: "memory");
            const unsigned og = xb_add(&bar[XB_TOP], 1u);
            const unsigned tg = og / nx;
            if (og + 1u == (tg + 1u) * nx) xb_add(&bar[XB_TOPGEN], 1u);
            else XB_SPIN(xb_ld(&bar[XB_TOPGEN]) == tg, bar);
            __builtin_amdgcn_fence(__ATOMIC_ACQUIRE, "agent");
            xb_add(&bar[XB_XGEN(b.x)], 1u);
            asm volatile("s_waitcnt vmcnt(0)" ::: "memory");
        } else {
            XB_SPIN(xb_ld(&bar[XB_XGEN(b.x)]) == gen, bar);
            __builtin_amdgcn_fence(__ATOMIC_ACQUIRE, "agent");
            asm volatile("s_waitcnt vmcnt(0)" ::: "memory");
        }
    }
    __syncthreads();
}


__device__ __forceinline__ float bf2f(unsigned short u) { return __uint_as_float((unsigned)u << 16); }
__device__ __forceinline__ unsigned pk2(float lo, float hi) { return pg8::cvt_pk_bf16(lo, hi); }
__device__ __forceinline__ float wave_sum(float v) {
#pragma unroll
    for (int o = 1; o < 64; o <<= 1) v += __shfl_xor(v, o);
    return v;
}
__device__ __forceinline__ float fast_exp2(float x) { return __builtin_amdgcn_exp2f(x); }
__device__ __forceinline__ float fast_rcp(float x) { return __builtin_amdgcn_rcpf(x); }
__device__ __forceinline__ float silu_f(float x) { return x * fast_rcp(1.0f + fast_exp2(-x * LOG2E)); }
__device__ __forceinline__ f32x4 mfma16(bf16x8 a, bf16x8 b, f32x4 c) { return __builtin_amdgcn_mfma_f32_16x16x32_bf16(a, b, c, 0, 0, 0); }

struct EpiGen {
    static constexpr bool PERM = true, AFTER_DRAIN = false;
    bf16_t* O; int ldc; int mode; unsigned char* wsz;
    __device__ __forceinline__ void operator()(const pg8::f32x4 (&acc)[2][2][4][2], const pg8::Unit& u, int wr, int wc, int fr, int fq) const {
        const int row0 = u.pm * 256 + wr * 64 + fr;
        int colt = u.pn * 256; bf16_t* base = O; int ld = ldc; bool rope = false;
        if (mode == 1) { if (u.pn < 4) rope = true; else if (u.pn >= 12) { base = (bf16_t*)(wsz + ZB_KV); ld = 512; colt = (u.pn - 12) * 256; rope = (u.pn == 12); } }
        const int col0 = colt + wc * 32 + 8 * fq;
        if (rope) {
            const int i0 = (col0 & 63) >> 1; const float* cosT = (const float*)(wsz + ZB_COS); const float* sinT = (const float*)(wsz + ZB_SIN);
#pragma unroll
            for (int ai = 0; ai < 2; ++ai)
#pragma unroll
                for (int m = 0; m < 4; ++m) {
                    const int row = row0 + ai * 128 + m * 16;
                    const f32x4 cs = *(const f32x4*)(cosT + (size_t)row * 32 + i0), sn = *(const f32x4*)(sinT + (size_t)row * 32 + i0);
                    bf16_t* rowp = base + (size_t)row * ld + col0;
#pragma unroll
                    for (int bj = 0; bj < 2; ++bj) {
                        const f32x4 v0 = acc[ai][bj][m][0], v1 = acc[ai][bj][m][1];
                        u32x4 w;
                        w.x = pk2(v0[0] * cs[0] - v0[1] * sn[0], v0[1] * cs[0] + v0[0] * sn[0]);
                        w.y = pk2(v0[2] * cs[1] - v0[3] * sn[1], v0[3] * cs[1] + v0[2] * sn[1]);
                        w.z = pk2(v1[0] * cs[2] - v1[1] * sn[2], v1[1] * cs[2] + v1[0] * sn[2]);
                        w.w = pk2(v1[2] * cs[3] - v1[3] * sn[3], v1[3] * cs[3] + v1[2] * sn[3]);
                        *(u32x4*)(rowp + bj * 128) = w;
                    }
                }
        } else {
#pragma unroll
            for (int ai = 0; ai < 2; ++ai)
#pragma unroll
                for (int m = 0; m < 4; ++m) {
                    bf16_t* rowp = base + (size_t)(row0 + ai * 128 + m * 16) * ld + col0;
#pragma unroll
                    for (int bj = 0; bj < 2; ++bj) {
                        const f32x4 v0 = acc[ai][bj][m][0], v1 = acc[ai][bj][m][1];
                        u32x4 w; w.x = pk2(v0[0], v0[1]); w.y = pk2(v0[2], v0[3]); w.z = pk2(v1[0], v1[1]); w.w = pk2(v1[2], v1[3]);
                        *(u32x4*)(rowp + bj * 128) = w;
                    }
                }
        }
    }
};

__device__ __forceinline__ void transpose_item(const float* W, int K, int N, bf16_t* WT, int row_off, const float* gain, int perm_lim, LAS float* scr, int item, int lane) {
    const int nblk = N / 32, kb = item / nblk, nb = item % nblk, k0 = 64 * kb, n0 = 32 * nb;
#pragma unroll 8
    for (int i = 0; i < 32; ++i) { const int kk = 2 * i + (lane >> 5); const float gk = gain ? gain[k0 + kk] : 1.0f; scr[kk * 33 + (lane & 31)] = W[(size_t)(k0 + kk) * N + n0 + (lane & 31)] * gk; }
    asm volatile("s_waitcnt lgkmcnt(0)" ::: "memory");
    const int c = lane & 7;
#pragma unroll
    for (int j = 0; j < 4; ++j) {
        const int n = (lane >> 3) + 8 * j; const LAS float* s = scr + (8 * c) * 33 + n;
        u32x4 o; o.x = pk2(s[0 * 33], s[1 * 33]); o.y = pk2(s[2 * 33], s[3 * 33]); o.z = pk2(s[4 * 33], s[5 * 33]); o.w = pk2(s[6 * 33], s[7 * 33]);
        const int ng = n0 + n; const int dst = (ng < perm_lim) ? ((ng & ~63) + 2 * (ng & 31) + ((ng >> 5) & 1)) : ng;
        *(u32x4*)(WT + (size_t)(row_off + dst) * K + k0 + 8 * c) = o;
    }
    asm volatile("s_waitcnt lgkmcnt(0)" ::: "memory");
}
__device__ __forceinline__ void xhat_row(const float* xrow, bf16_t* orow, int lane) {
    const f32x4* xr = (const f32x4*)xrow + lane; f32x4 v[4]; float s = 0.f;
#pragma unroll
    for (int j = 0; j < 4; ++j) { v[j] = xr[64 * j]; s += (v[j][0] * v[j][0] + v[j][1] * v[j][1]) + (v[j][2] * v[j][2] + v[j][3] * v[j][3]); }
    const float r = 1.0f / sqrtf(wave_sum(s) * (1.0f / 1024.0f) + EPS);
    u32x2* o = (u32x2*)orow + lane;
#pragma unroll
    for (int j = 0; j < 4; ++j) { u32x2 w; w.x = pk2(v[j][0] * r, v[j][1] * r); w.y = pk2(v[j][2] * r, v[j][3] * r); o[64 * j] = w; }
}
__device__ __forceinline__ void norm_row(const bf16_t* yrow, const float* hin, const float* gpost, float* hout, bf16_t* xnrow, bool write_xn, int lane, bool dry) {
    const u32x2* yr = (const u32x2*)yrow + lane; f32x4 y[4]; float s = 0.f;
#pragma unroll
    for (int j = 0; j < 4; ++j) { const u32x2 w = yr[64 * j]; y[j][0] = __uint_as_float(w.x << 16); y[j][1] = __uint_as_float(w.x & 0xffff0000u); y[j][2] = __uint_as_float(w.y << 16); y[j][3] = __uint_as_float(w.y & 0xffff0000u);
        s += (y[j][0] * y[j][0] + y[j][1] * y[j][1]) + (y[j][2] * y[j][2] + y[j][3] * y[j][3]); }
    const float r = 1.0f / sqrtf(wave_sum(s) * (1.0f / 1024.0f) + EPS);
    const f32x4* hr = (const f32x4*)hin + lane; const f32x4* gr = (const f32x4*)gpost + lane; f32x4* ho = (f32x4*)hout + lane; float s2 = 0.f;
#pragma unroll
    for (int j = 0; j < 4; ++j) { const f32x4 h = hr[64 * j] + y[j] * r * gr[64 * j]; y[j] = h; if (!dry) ho[64 * j] = h; s2 += (h[0] * h[0] + h[1] * h[1]) + (h[2] * h[2] + h[3] * h[3]); }
    if (write_xn && !dry) {
        const float r2 = 1.0f / sqrtf(wave_sum(s2) * (1.0f / 1024.0f) + EPS);
        u32x2* o = (u32x2*)xnrow + lane;
#pragma unroll
        for (int j = 0; j < 4; ++j) { u32x2 w; w.x = pk2(y[j][0] * r2, y[j][1] * r2); w.y = pk2(y[j][2] * r2, y[j][3] * r2); o[64 * j] = w; }
    }
}

template <int D, int NK, bool SWA>
__device__ __forceinline__ void attn_rowtile2(const LAS unsigned char* Kl, const LAS unsigned char* VT, const bf16_t* qptr, const bf16_t* gptr, bf16_t* optr, float sc2, float sink2, int irow, bool first_blk, int c, int g, bool dry) {
    constexpr int KSTR = (D + 8) * 2, VSTR = (NK + 8) * 2, NKT = NK / 16, NKK = D / 32, NDT = D / 16, NK2 = NK / 32;
    bf16x8 qf[NKK];
#pragma unroll
    for (int kk = 0; kk < NKK; ++kk) qf[kk] = *(const bf16x8*)(qptr + kk * 32 + g * 8);
    f32x4 st[NKT];
#pragma unroll
    for (int kt = 0; kt < NKT; ++kt) {
        f32x4 a = {0.f, 0.f, 0.f, 0.f};
#pragma unroll
        for (int kk = 0; kk < NKK; ++kk) { const bf16x8 kf = *(const LAS bf16x8*)(Kl + (16 * kt + c) * KSTR + kk * 64 + g * 16); a = mfma16(kf, qf[kk], a); }
        st[kt] = a;
    }
    float m = -INFINITY;
#pragma unroll
    for (int kt = 0; kt < NKT; ++kt)
#pragma unroll
        for (int r = 0; r < 4; ++r) {
            float x = st[kt][r] * sc2;
            if (SWA) { const int j = 16 * kt + 4 * g + r; const bool ok = (j > irow) && (j <= irow + 128) && (!first_blk || j >= 128); x = ok ? x : -INFINITY; }
            st[kt][r] = x; m = fmaxf(m, x);
        }
    m = fmaxf(m, __shfl_xor(m, 16)); m = fmaxf(m, __shfl_xor(m, 32));
    if (SWA) m = fmaxf(m, sink2);
    float l = 0.f;
#pragma unroll
    for (int kt = 0; kt < NKT; ++kt)
#pragma unroll
        for (int r = 0; r < 4; ++r) { const float p = fast_exp2(st[kt][r] - m); st[kt][r] = p; l += p; }
    l += __shfl_xor(l, 16); l += __shfl_xor(l, 32);
    if (SWA) l += fast_exp2(sink2 - m);
    const float inv = 1.0f / l;
    bf16x8 pf[NK2];
#pragma unroll
    for (int k2 = 0; k2 < NK2; ++k2) {
        u32x4 w; w.x = pk2(st[2 * k2][0], st[2 * k2][1]); w.y = pk2(st[2 * k2][2], st[2 * k2][3]); w.z = pk2(st[2 * k2 + 1][0], st[2 * k2 + 1][1]); w.w = pk2(st[2 * k2 + 1][2], st[2 * k2 + 1][3]);
        pf[k2] = __builtin_bit_cast(bf16x8, w);
    }
#pragma unroll
    for (int dt = 0; dt < NDT; ++dt) {
        f32x4 a = {0.f, 0.f, 0.f, 0.f};
#pragma unroll
        for (int k2 = 0; k2 < NK2; ++k2) {
            const LAS unsigned char* vp = VT + (16 * dt + c) * VSTR + (32 * k2 + 4 * g) * 2;
            const u32x2 lo = *(const LAS u32x2*)vp, hi = *(const LAS u32x2*)(vp + 32);
            u32x4 w; w.x = lo.x; w.y = lo.y; w.z = hi.x; w.w = hi.y;
            a = mfma16(__builtin_bit_cast(bf16x8, w), pf[k2], a);
        }
        const u32x2 gw = *(const u32x2*)(gptr + 16 * dt + 4 * g);
        const float g0 = __uint_as_float(gw.x << 16), g1 = __uint_as_float(gw.x & 0xffff0000u), g2 = __uint_as_float(gw.y << 16), g3 = __uint_as_float(gw.y & 0xffff0000u);
        u32x2 o; o.x = pk2(a[0] * inv * silu_f(g0), a[1] * inv * silu_f(g1)); o.y = pk2(a[2] * inv * silu_f(g2), a[3] * inv * silu_f(g3));
        if (!dry) *(u32x2*)(optr + 16 * dt + 4 * g) = o;
    }
}

__device__ __forceinline__ void vt_scatter(LAS unsigned char* vt_base, int vstr, u32x4 v) {
    LAS unsigned short* p = (LAS unsigned short*)vt_base; const int s = vstr >> 1;
    p[0 * s] = (unsigned short)(v.x & 0xffffu); p[1 * s] = (unsigned short)(v.x >> 16); p[2 * s] = (unsigned short)(v.y & 0xffffu); p[3 * s] = (unsigned short)(v.y >> 16);
    p[4 * s] = (unsigned short)(v.z & 0xffffu); p[5 * s] = (unsigned short)(v.z >> 16); p[6 * s] = (unsigned short)(v.w & 0xffffu); p[7 * s] = (unsigned short)(v.w >> 16);
}
__device__ __forceinline__ void mem_unit(LAS unsigned char* lds, int u, int l, const bf16_t* MKV, bf16_t* Z, int ldz, int qcol, int gcol, int tid, bool dry) {
    constexpr int D = 128, NK = 256, KSTR = (D + 8) * 2, VSTR = (NK + 8) * 2;
    LAS unsigned char* Kl = lds; LAS unsigned char* VT = lds + NK * KSTR;
    const int tile = u >> 2, hm = u & 3, b = tile >> 3;
    const bf16_t* kv = MKV + (size_t)(b * 256) * 4096 + l * 1024 + hm * 128;
#pragma unroll 4
    for (int i = 0; i < 8; ++i) {
        const int p = tid + 512 * i, key = p >> 4, c8 = p & 15;
        const u32x4 kq = *(const u32x4*)(kv + (size_t)key * 4096 + c8 * 8);
        const u32x4 vq = *(const u32x4*)(kv + (size_t)key * 4096 + 512 + c8 * 8);
        *(LAS u32x4*)(Kl + key * KSTR + c8 * 16) = kq;
        vt_scatter(VT + (c8 * 8) * VSTR + key * 2, VSTR, vq);
    }
    __syncthreads();
    const int w = tid >> 6, lane = tid & 63, c = lane & 15, g = lane >> 4;
    const float sc2 = 0.08838834764831845f * LOG2E;
#pragma unroll 1
    for (int rt = 0; rt < 2; ++rt) {
        const int tok = tile * 256 + w * 32 + rt * 16 + c;
        bf16_t* row = Z + (size_t)tok * ldz;
        attn_rowtile2<D, NK, false>(Kl, VT, row + qcol + hm * 128, row + gcol + hm * 128, row + qcol + hm * 128, sc2, 0.f, 0, false, c, g, dry);
    }
    __syncthreads();
}
__device__ __forceinline__ void swa_unit(LAS unsigned char* lds, int u, const bf16_t* KV, bf16_t* Z, const float* sinks, int tid, bool dry) {
    constexpr int D = 64, NK = 256, KSTR = (D + 8) * 2, VSTR = (NK + 8) * 2;
    LAS unsigned char* Kl = lds; LAS unsigned char* VT = lds + NK * KSTR;
    const int nb = u & 15, kvh = (u >> 4) & 3, b = u >> 6;
#pragma unroll
    for (int i = 0; i < 4; ++i) {
        const int p = tid + 512 * i, key = p >> 3, c8 = p & 7, pos = (nb - 1) * 128 + key;
        u32x4 kq = {0u, 0u, 0u, 0u}, vq = {0u, 0u, 0u, 0u};
        if (pos >= 0) { const bf16_t* src = KV + (size_t)(b * SEQ + pos) * 512 + kvh * 64 + c8 * 8; kq = *(const u32x4*)src; vq = *(const u32x4*)(src + 256); }
        *(LAS u32x4*)(Kl + key * KSTR + c8 * 16) = kq;
        vt_scatter(VT + (c8 * 8) * VSTR + key * 2, VSTR, vq);
    }
    __syncthreads();
    const int w = tid >> 6, lane = tid & 63, c = lane & 15, g = lane >> 4;
    const int hq = kvh * 4 + (w >> 1);
    const float sink2 = sinks[hq] * LOG2E;
#pragma unroll 1
    for (int rt = 0; rt < 4; ++rt) {
        const int i = (w & 1) * 64 + rt * 16 + c;
        bf16_t* row = Z + (size_t)(b * SEQ + nb * 128 + i) * B_IN;
        attn_rowtile2<D, NK, true>(Kl, VT, row + hq * 64, row + 1024 + hq * 64, row + 1024 + hq * 64, 0.125f * LOG2E, sink2, i, nb == 0, c, g, dry);
    }
    __syncthreads();
}
__device__ __forceinline__ void hgrn_unit(LAS unsigned char* lds, bf16_t* Zb, int h, int layer, const float* lblog, const float* gnorm, int tid, bool dry) {
    constexpr int L_RAWQ = 0, L_RAWF = 16384, L_OBUF = 0, L_RAWG = 32768, L_VT = 49152, L_QH = 67584, L_QT = 84992, L_KT = 102400, L_KHT = 119808, L_P15 = 144384;
    constexpr int VTS = 144, QS = 272;
    const int lane = tid & 63, w = tid >> 6, c = lane & 15, g = lane >> 4;
    const int kc = tid & 127, blk = tid >> 7;
    float lbv;
    { const int chn = h * 128 + kc; const float a0 = lblog[chn], a1 = lblog[1024 + chn], a2 = lblog[2048 + chn]; const float mx = fmaxf(a0, fmaxf(a1, a2));
      const float e0 = expf(a0 - mx), e1 = expf(a1 - mx), e2 = expf(a2 - mx); lbv = (layer == 0 ? e0 : e0 + e1) / (e0 + e1 + e2); }
    const float oml = 1.0f - lbv;
    const int t4 = tid >> 3, vs = (tid & 7) * 16;
    f32x4 gn[4];
#pragma unroll
    for (int i = 0; i < 4; ++i) gn[i] = *(const f32x4*)(gnorm + vs + 4 * i);
    f32x4 S[8];
#pragma unroll
    for (int i = 0; i < 8; ++i) S[i] = (f32x4){0.f, 0.f, 0.f, 0.f};
    u32x4 rq[2], rf[2], rv[2], rg[2];
    const bf16_t* zh = Zb + h * 128;
#pragma unroll
    for (int i = 0; i < 2; ++i) { const int p = tid + 512 * i, row = p >> 4, c8 = p & 15; const bf16_t* src = zh + (size_t)row * A_IN + c8 * 8;
        rq[i] = *(const u32x4*)src; rf[i] = *(const u32x4*)(src + 1024); rv[i] = *(const u32x4*)(src + 2048); rg[i] = *(const u32x4*)(src + 3072); }
#pragma unroll 1
    for (int ch = 0; ch < 32; ++ch) {
#pragma unroll
        for (int i = 0; i < 2; ++i) { const int p = tid + 512 * i, row = p >> 4, c8 = p & 15;
            *(LAS u32x4*)(lds + L_RAWQ + row * 256 + c8 * 16) = rq[i]; *(LAS u32x4*)(lds + L_RAWF + row * 256 + c8 * 16) = rf[i]; *(LAS u32x4*)(lds + L_RAWG + row * 256 + c8 * 16) = rg[i];
            vt_scatter(lds + L_VT + (c8 * 8) * VTS + row * 2, VTS, rv[i]); }
        if (ch + 1 < 32) {
#pragma unroll
            for (int i = 0; i < 2; ++i) { const int p = tid + 512 * i, row = p >> 4, c8 = p & 15; const bf16_t* src = zh + (size_t)((ch + 1) * 64 + row) * A_IN + c8 * 8;
                rq[i] = *(const u32x4*)src; rf[i] = *(const u32x4*)(src + 1024); rv[i] = *(const u32x4*)(src + 2048); rg[i] = *(const u32x4*)(src + 3072); }
        }
        __syncthreads();
        {
            float P[16], kk[16], qs[16]; float run = 1.0f;
            const LAS unsigned short* rF = (const LAS unsigned short*)(lds + L_RAWF) + (16 * blk) * 128 + kc;
            const LAS unsigned short* rQ = (const LAS unsigned short*)(lds + L_RAWQ) + (16 * blk) * 128 + kc;
#pragma unroll
            for (int s = 0; s < 16; ++s) {
                float fp = bf2f(rF[s * 128]); const float qp = bf2f(rQ[s * 128]);
                fp = fminf(fmaxf(fp, -30.f), 30.f);
                const float e = fast_exp2(-fp * LOG2E), sg = fast_rcp(1.0f + e);
                const float f = lbv + oml * sg; run *= f; P[s] = fmaxf(run, 1e-30f); kk[s] = oml * (e * sg);
                qs[s] = silu_f(qp);
            }
            const float P7 = P[7], P15 = P[15], iP7 = fast_rcp(P7), r157 = P15 * iP7;
            LAS unsigned short* qh = (LAS unsigned short*)(lds + L_QH) + (16 * blk) * (QS / 2) + kc;
            LAS unsigned short* qt = (LAS unsigned short*)(lds + L_QT) + (16 * blk) * (QS / 2) + kc;
            LAS unsigned short* kt = (LAS unsigned short*)(lds + L_KT) + (16 * blk) * (QS / 2) + kc;
            float khv[16];
#pragma unroll
            for (int s = 0; s < 16; ++s) {
                const float qhv = qs[s] * P[s], qtv = qhv * iP7, ktv = kk[s] * P7 * fast_rcp(P[s]);
                khv[s] = ktv * r157;
                qh[s * (QS / 2)] = (unsigned short)pk2(qhv, qhv); qt[s * (QS / 2)] = (unsigned short)pk2(qtv, qtv); kt[s * (QS / 2)] = (unsigned short)pk2(ktv, ktv);
            }
            u32x4 k0, k1; k0.x = pk2(khv[0], khv[1]); k0.y = pk2(khv[2], khv[3]); k0.z = pk2(khv[4], khv[5]); k0.w = pk2(khv[6], khv[7]);
            k1.x = pk2(khv[8], khv[9]); k1.y = pk2(khv[10], khv[11]); k1.z = pk2(khv[12], khv[13]); k1.w = pk2(khv[14], khv[15]);
            *(LAS u32x4*)(lds + L_KHT + (blk * 128 + kc) * 48) = k0; *(LAS u32x4*)(lds + L_KHT + (blk * 128 + kc) * 48 + 16) = k1;
            *(LAS float*)(lds + L_P15 + (blk * 128 + kc) * 4) = P15;
        }
        __syncthreads();
#pragma unroll 1
        for (int b2 = 0; b2 < 4; ++b2) {
            const int tb = 16 * b2;
            f32x4 aS = {0.f, 0.f, 0.f, 0.f};
#pragma unroll
            for (int k4 = 0; k4 < 4; ++k4) {
                const bf16x8 a = *(const LAS bf16x8*)(lds + L_KT + (tb + c) * QS + k4 * 64 + g * 16);
                const bf16x8 b = *(const LAS bf16x8*)(lds + L_QT + (tb + c) * QS + k4 * 64 + g * 16);
                aS = mfma16(a, b, aS);
            }
#pragma unroll
            for (int r = 0; r < 4; ++r) if (4 * g + r > c) aS[r] = 0.f;
            u32x4 pw; pw.x = pk2(aS[0], aS[1]); pw.y = pk2(aS[2], aS[3]); pw.z = 0u; pw.w = 0u;
            const u32x2 vv = *(const LAS u32x2*)(lds + L_VT + (16 * w + c) * VTS + (tb + 4 * g) * 2);
            u32x4 vw; vw.x = vv.x; vw.y = vv.y; vw.z = 0u; vw.w = 0u;
            f32x4 aO = mfma16(__builtin_bit_cast(bf16x8, pw), __builtin_bit_cast(bf16x8, vw), (f32x4){0.f, 0.f, 0.f, 0.f});
#pragma unroll
            for (int k4 = 0; k4 < 4; ++k4) {
                const LAS unsigned char* qp = lds + L_QH + (tb + c) * QS + (32 * k4 + 4 * g) * 2;
                const u32x2 q0 = *(const LAS u32x2*)qp, q1 = *(const LAS u32x2*)(qp + 32);
                u32x4 qa; qa.x = q0.x; qa.y = q0.y; qa.z = q1.x; qa.w = q1.y;
                u32x4 sb; sb.x = pk2(S[2 * k4][0], S[2 * k4][1]); sb.y = pk2(S[2 * k4][2], S[2 * k4][3]); sb.z = pk2(S[2 * k4 + 1][0], S[2 * k4 + 1][1]); sb.w = pk2(S[2 * k4 + 1][2], S[2 * k4 + 1][3]);
                aO = mfma16(__builtin_bit_cast(bf16x8, qa), __builtin_bit_cast(bf16x8, sb), aO);
            }
#pragma unroll
            for (int r = 0; r < 4; ++r) *(LAS float*)(lds + L_OBUF + ((tb + 4 * g + r) * 128 + 16 * w + c) * 4) = aO[r];
            u32x4 vb = {0u, 0u, 0u, 0u};
            if (g < 2) vb = *(const LAS u32x4*)(lds + L_VT + (16 * w + c) * VTS + (tb + 8 * g) * 2);
#pragma unroll
            for (int kt = 0; kt < 8; ++kt) {
                const f32x4 p = *(const LAS f32x4*)(lds + L_P15 + (b2 * 128 + 16 * kt + 4 * g) * 4);
                u32x4 ka = {0u, 0u, 0u, 0u};
                if (g < 2) ka = *(const LAS u32x4*)(lds + L_KHT + (b2 * 128 + 16 * kt + c) * 48 + g * 16);
                S[kt] = mfma16(__builtin_bit_cast(bf16x8, ka), __builtin_bit_cast(bf16x8, vb), S[kt] * p);
            }
        }
        __syncthreads();
        {
            f32x4 o[4]; float ss = 0.f;
#pragma unroll
            for (int i = 0; i < 4; ++i) { o[i] = *(const LAS f32x4*)(lds + L_OBUF + (t4 * 128 + vs + 4 * i) * 4); ss += (o[i][0] * o[i][0] + o[i][1] * o[i][1]) + (o[i][2] * o[i][2] + o[i][3] * o[i][3]); }
            ss += __shfl_xor(ss, 1); ss += __shfl_xor(ss, 2); ss += __shfl_xor(ss, 4);
            const float r = 1.0f / sqrtf(ss * (1.0f / 128.0f) + EPS);
            const u32x4 ga = *(const LAS u32x4*)(lds + L_RAWG + t4 * 256 + vs * 2), gb = *(const LAS u32x4*)(lds + L_RAWG + t4 * 256 + vs * 2 + 16);
            const unsigned gwv[8] = {ga.x, ga.y, ga.z, ga.w, gb.x, gb.y, gb.z, gb.w};
            unsigned ow[8];
#pragma unroll
            for (int i = 0; i < 8; ++i) {
                const float g0 = __uint_as_float(gwv[i] << 16), g1 = __uint_as_float(gwv[i] & 0xffff0000u);
                const float o0 = o[i >> 1][(i & 1) * 2], o1 = o[i >> 1][(i & 1) * 2 + 1];
                const float n0 = gn[i >> 1][(i & 1) * 2], n1 = gn[i >> 1][(i & 1) * 2 + 1];
                ow[i] = pk2(o0 * r * n0 * silu_f(g0), o1 * r * n1 * silu_f(g1));
            }
            bf16_t* dst = Zb + (size_t)(ch * 64 + t4) * A_IN + 3072 + h * 128 + vs;
            u32x4 w0, w1; w0.x = ow[0]; w0.y = ow[1]; w0.z = ow[2]; w0.w = ow[3]; w1.x = ow[4]; w1.y = ow[5]; w1.z = ow[6]; w1.w = ow[7];
            if (!dry) { *(u32x4*)dst = w0; *(u32x4*)(dst + 8) = w1; }
        }
        __syncthreads();
    }
}

struct Args { const float* in[16]; float* out; unsigned char* ws; int ph_lo, ph_hi, probe, pad; };
constexpr int N_PHASES = 18;

__global__ void __launch_bounds__(512, 2) fwd_kernel(Args a) {
    extern __shared__ __attribute__((aligned(16))) unsigned char lds_raw[];
    LAS unsigned char* lds = (LAS unsigned char*)lds_raw;
    cg::grid_group grid = cg::this_grid();
    const int G = gridDim.x, bx = blockIdx.x;
    unsigned char* ws = a.ws;
    bf16_t* Z = (bf16_t*)(ws + WS_Z); bf16_t* XN = (bf16_t*)(ws + WS_XN); bf16_t* MKV = (bf16_t*)(ws + WS_MKV);

    volatile LAS unsigned* bst = (volatile LAS unsigned*)(lds + LDS_BYTES - 64);
    if (threadIdx.x < 2) bst[threadIdx.x] = 0u;
    __syncthreads();
    const XcdBarrier xbar = xcd_barrier_post((unsigned*)ws, bst);
#pragma unroll 1
    for (int ph = a.ph_lo; ph < a.ph_hi; ++ph) {
        const int l = (ph - 2) >> 2, sub = (ph - 2) & 3;
        const bool is_gemm = (ph == 1) || (ph >= 2 && (sub == 0 || sub == 2));
        const int cls = (ph <= 1) ? 6 : (sub == 0 ? 1 : (sub == 2 ? 2 : (sub == 1 ? (l < 2 ? 3 : 4) : 5)));
        const int nrep = (a.probe == cls) ? 2 : 1;
#pragma unroll 1
        for (int rep = 0; rep < nrep; ++rep) {
        const bool dry = rep + 1 < nrep;
        int tid = threadIdx.x; asm volatile("" : "+v"(tid));
        const int lane = tid & 63, wave = __builtin_amdgcn_readfirstlane(tid >> 6);
        const int gw = bx * 8 + wave, NGW = G * 8;
        LAS float* scr = (LAS float*)(lds + wave * 16384);
        if (ph == 0) {
            constexpr int I_IN = 16 * 160, I_OUT = 24 * 32, I_MEM = 16 * 32, NIT = 2 * I_IN + 2 * I_OUT + 4 * I_MEM;
            for (int it = gw; it < NIT; it += NGW) {
                int r = it;
                if (r < 2 * I_IN) { const int li = r / I_IN; r -= li * I_IN;
                    transpose_item(a.in[7] + (size_t)li * DM * A_IN, DM, A_IN, (bf16_t*)(ws + WS_WA_IN) + (size_t)li * A_IN * DM, 0, a.in[3] + li * DM, 0, scr, r, lane); continue; }
                r -= 2 * I_IN;
                if (r < 2 * I_OUT) { const int li = r / I_OUT; r -= li * I_OUT;
                    transpose_item(a.in[10] + (size_t)li * OUT_K * DM, OUT_K, DM, (bf16_t*)(ws + WS_WA_OUT) + (size_t)li * DM * OUT_K, 0, nullptr, 0, scr, r, lane); continue; }
                r -= 2 * I_OUT;
                { const int li = r / I_MEM; r -= li * I_MEM;
                    transpose_item(a.in[6] + (size_t)li * DM * 1024, DM, 1024, (bf16_t*)(ws + WS_Z + ZT_WMEM), li * 1024, a.in[5] + li * DM, 0, scr, r, lane); }
            }
            for (int m = gw; m < NTOK; m += NGW) xhat_row(a.in[0] + (size_t)m * DM, XN + (size_t)m * DM, lane);
            for (int m = gw; m < 2048; m += NGW) xhat_row(a.in[1] + (size_t)m * DM, (bf16_t*)(ws + WS_Z + ZT_MEMHAT) + (size_t)m * DM, lane);
        } else if (is_gemm) {
            pg8::Gemm gm; EpiGen E; E.mode = 0; E.wsz = ws + WS_Z;
            if (ph == 1) { gm.A = (const bf16_t*)(ws + WS_Z + ZT_MEMHAT); gm.Bt = (const bf16_t*)(ws + WS_Z + ZT_WMEM); gm.M = 2048; gm.N = 4096; gm.K = 1024; gm.lda = 1024; E.O = MKV; E.ldc = 4096; }
            else if (sub == 0) {
                gm.A = XN; gm.M = NTOK; gm.K = DM; gm.lda = DM; E.O = Z;
                if (l < 2) { gm.Bt = (const bf16_t*)(ws + WS_WA_IN) + (size_t)l * A_IN * DM; gm.N = A_IN; E.ldc = A_IN; }
                else { gm.Bt = (const bf16_t*)(ws + WS_Z + (l == 2 ? ZB_WIN0 : ZB_WIN1)); gm.N = (l == 2) ? 3584 : 3072; E.ldc = B_IN; E.mode = 1; }
            } else {
                gm.M = NTOK; gm.N = DM; gm.K = OUT_K; E.O = XN; E.ldc = DM;
                if (l < 2) { gm.A = Z + 3072; gm.lda = A_IN; gm.Bt = (const bf16_t*)(ws + WS_WA_OUT) + (size_t)l * DM * OUT_K; }
                else { gm.A = Z + 1024; gm.lda = B_IN; gm.Bt = (const bf16_t*)(ws + WS_Z + ZB_WOUT) + (size_t)(l - 2) * DM * OUT_K; }
            }
            pg8::StaticOrder S; S.init(gm.M, gm.N, G, bx);
            if (gm.K == 1024) pg8::gemm_phase<EpiGen, pg8::StaticOrder, true, true, 1024, 1024>(lds, gm, S, E);
            else if (gm.lda == A_IN) pg8::gemm_phase<EpiGen, pg8::StaticOrder, true, true, 1536, A_IN>(lds, gm, S, E);
            else pg8::gemm_phase<EpiGen, pg8::StaticOrder, true, true, 1536, B_IN>(lds, gm, S, E);
        } else if (sub == 1) {
            if (l < 2) {
                if (bx < 64) hgrn_unit(lds, Z + (size_t)(bx >> 3) * SEQ * A_IN, bx & 7, l, a.in[8], a.in[9] + l * 1024 + (bx & 7) * 128, tid, dry);
                else for (int u = bx - 64; u < 256; u += G - 64) mem_unit(lds, u, l, MKV, Z, A_IN, 4096, 4608, tid, dry);
            } else {
                for (int u = bx; u < 768; u += G) {
                    if (u < 512) swa_unit(lds, u, (const bf16_t*)(ws + WS_Z + ZB_KV), Z, a.in[14] + (l - 2) * 16, tid, dry);
                    else mem_unit(lds, u - 512, l, MKV, Z, B_IN, 2048, 2560, tid, dry);
                }
            }
        } else {
            const float* hin = (l == 0) ? a.in[0] : a.out;
            for (int m = gw; m < NTOK; m += NGW) norm_row(XN + (size_t)m * DM, hin + (size_t)m * DM, a.in[4] + l * DM, a.out + (size_t)m * DM, XN + (size_t)m * DM, l < 3, lane, dry);
            if (l == 1) {
                constexpr int I_BIN = 16 * 96, I_KV = 16 * 16, I_OUT = 24 * 32, NIT = 2 * I_BIN + I_KV + 2 * I_OUT;
                for (int it = gw; it < NIT; it += NGW) {
                    int r = it;
                    if (r < I_BIN) { transpose_item(a.in[13], DM, B_IN, (bf16_t*)(ws + WS_Z + ZB_WIN0), 0, a.in[3] + 2 * DM, 1024, scr, r, lane); continue; } r -= I_BIN;
                    if (r < I_KV) { transpose_item(a.in[12], DM, 512, (bf16_t*)(ws + WS_Z + ZB_WIN0), 3072, a.in[11], 256, scr, r, lane); continue; } r -= I_KV;
                    if (r < I_BIN) { transpose_item(a.in[13] + (size_t)DM * B_IN, DM, B_IN, (bf16_t*)(ws + WS_Z + ZB_WIN1), 0, a.in[3] + 3 * DM, 1024, scr, r, lane); continue; } r -= I_BIN;
                    { const int li = r / I_OUT; r -= li * I_OUT;
                      transpose_item(a.in[15] + (size_t)li * OUT_K * DM, OUT_K, DM, (bf16_t*)(ws + WS_Z + ZB_WOUT) + (size_t)li * DM * OUT_K, 0, nullptr, 0, scr, r, lane); }
                }
                const int* pos = (const int*)a.in[2]; float* cT = (float*)(ws + WS_Z + ZB_COS); float* sT = (float*)(ws + WS_Z + ZB_SIN);
                for (int e = bx * 512 + tid; e < NTOK * 32; e += G * 512) {
                    const int i = e & 31; const float inv_freq = exp2f(-(float)(2 * i) * (13.287712379549449f / 64.0f));
                    const float ang = (float)pos[e >> 5] * inv_freq;
                    cT[e] = cosf(ang); sT[e] = sinf(ang);
                }
            }
        }
        }
        if (ph + 1 < a.ph_hi) { if (a.probe == 99) grid.sync(); else xcd_barrier(xbar); }
    }
}

#ifndef MK_PER_PHASE
#define MK_PER_PHASE 0
#endif
#define MK_PROBE 0
extern "C" void kernel_launch(void* const* d_in, const int* in_sizes, int n_in, void* d_out, int out_size, void* d_ws, size_t ws_size, hipStream_t stream) {
    static int grid = 0;
    if (grid == 0) {
        if (n_in != 16 || ws_size < WS_END) { fprintf(stderr, "kernel_launch: unexpected n_in %d / ws %zu\n", n_in, ws_size); grid = -1; return; }
        if (hipFuncSetAttribute((const void*)fwd_kernel, hipFuncAttributeMaxDynamicSharedMemorySize, LDS_BYTES) != hipSuccess) { fprintf(stderr, "hipFuncSetAttribute failed\n"); grid = -1; return; }
        int dev = 0, cus = 0, per_cu = 0;
        hipGetDevice(&dev); hipDeviceGetAttribute(&cus, hipDeviceAttributeMultiprocessorCount, dev);
        hipOccupancyMaxActiveBlocksPerMultiprocessor(&per_cu, (const void*)fwd_kernel, 512, LDS_BYTES);
        (void)hipGetLastError();
        grid = 256;
        if (per_cu < 1 || cus < 256) fprintf(stderr, "kernel_launch: occupancy %d x %d CUs < 256 workgroups\n", per_cu, cus);
    }
    if (grid < 0) return;
    if (hipMemsetAsync(d_ws, 0, 16384, stream) != hipSuccess) { fprintf(stderr, "memset failed\n"); return; }
    Args a{};
    for (int i = 0; i < 16; ++i) a.in[i] = (const float*)d_in[i];
    a.out = (float*)d_out; a.ws = (unsigned char*)d_ws;
#if MK_PER_PHASE
    for (int ph = 0; ph < N_PHASES; ++ph) { a.ph_lo = ph; a.ph_hi = ph + 1; hipLaunchKernelGGL(fwd_kernel, dim3(grid), dim3(512), LDS_BYTES, stream, a); }
#else
    a.ph_lo = 0; a.ph_hi = N_PHASES; a.probe = MK_PROBE;
    void* args[] = {&a};
    hipError_t e = hipLaunchCooperativeKernel((const void*)fwd_kernel, dim3(grid), dim3(512), args, LDS_BYTES, stream);
    if (e != hipSuccess) fprintf(stderr, "cooperative launch failed: %s\n", hipGetErrorString(e));
#endif
}
```

```cpp
#include <hip/hip_runtime.h>
#include <hip/hip_cooperative_groups.h>
#include <cstdio>
#include <cstdint>
namespace cg = cooperative_groups;
namespace pg8 {
#define PG8_LAS __attribute__((address_space(3)))
typedef unsigned short bf16_t;
typedef short bf16x8 __attribute__((ext_vector_type(8)));
typedef float f32x4 __attribute__((ext_vector_type(4)));
typedef unsigned u32x4 __attribute__((ext_vector_type(4)));
constexpr int BM = 256, BK = 64, HALF = 128, HTB = HALF * BK * 2  , STAGE_BYTES = 8 * HTB, NXCD = 8, WGM = 8;

__host__ __device__ __forceinline__ int lds_byte(int r, int c) { const int st = (r >> 4) * 2 + (c >> 5), rr = r & 15, cc = c & 31, ob = rr * 64 + cc * 2; return st * 1024 + (ob ^ (((ob >> 9) & 1) << 5)); }
__host__ __device__ __forceinline__ void stage_rc(int b, int& R, int& C) { const int st = b / 1024, sb = b % 1024, swz = sb ^ (((sb >> 9) & 1) << 5); R = (st >> 1) * 16 + swz / 64; C = (st & 1) * 32 + (swz % 64) / 2; }
__host__ __device__ __forceinline__ int perm32(int rho) { const int n = rho >> 4, i = rho & 15; return 8 * (i >> 2) + 4 * n + (i & 3); }

struct Unit { int pm, pn; };
struct Gemm { const bf16_t* A; const bf16_t* Bt; int M, N, K, lda; };

struct StaticOrder {
    int nM, nN, nwg, G, c;
    __host__ __device__ void init(int M, int N, int G_, int c_) { nM = M / BM; nN = N / BM; nwg = nM * nN; G = G_; c = c_; }
    __host__ __device__ bool next(int i, Unit& u) const {
        const long L = (long)i * G + c; if (L >= nwg) return false;
        int wgid = (int)L; { const int q = nwg / NXCD, r = nwg % NXCD, xcd = wgid % NXCD, off = wgid / NXCD; wgid = (xcd < r ? xcd * (q + 1) : r * (q + 1) + (xcd - r) * q) + off; }
        const int nig = WGM * nN, gid = wgid / nig, fm = gid * WGM, gsz = (nM - fm) < WGM ? (nM - fm) : WGM;
        u.pm = fm + ((wgid % nig) % gsz); u.pn = (wgid % nig) / gsz; return true;
    }
    __device__ __forceinline__ void a_ready(const Unit&) const {}
    __device__ __forceinline__ void done(const Unit&) const {}
};

__device__ __forceinline__ unsigned cvt_pk_bf16(float lo, float hi) { unsigned r; asm volatile("v_cvt_pk_bf16_f32 %0, %1, %2" : "=v"(r) : "v"(lo), "v"(hi)); return r; }
template <class Epi, class Sched, bool ALIGN_EPI, bool SP2, int KC, int LDAC>
__device__ __forceinline__ void gemm_phase(PG8_LAS unsigned char* lds, const Gemm g, const Sched& S, const Epi& E) {
    const int tid = threadIdx.x, wid = __builtin_amdgcn_readfirstlane(tid >> 6), lane = tid & 63, wr = wid >> 2, wc = wid & 3, fr = lane & 15, fq = lane >> 4;
    constexpr int K = KC, nt = K / BK;
    unsigned voffA, voffB;
    { int R, C; stage_rc(tid * 16, R, C); const int Rb = Epi::PERM ? ((R & ~31) + perm32(R & 31)) : R;
        voffA = (unsigned)(R * LDAC + C) * 2u; voffB = (unsigned)(Rb * K + C) * 2u; }
    constexpr size_t p2offA = (size_t)64 * LDAC * 2, p2offB = (size_t)64 * K * 2;
    const size_t kstep = (size_t)(BK * 2);
    const size_t hstepA = (size_t)HALF * LDAC * 2, hstepB = (size_t)HALF * K * 2;
    const size_t tstepA = 2 * hstepA, tstepB = 2 * hstepB;
    const unsigned ldsw = (unsigned)wid * 1024u;
    const int aoff = lds_byte(wr * 64 + fr, fq * 8), boff = lds_byte(wc * 32 + fr, fq * 8);
#define PG8_SA(b, h) (((b) * 2 + (h)) * HTB)
#define PG8_SB(b, h) ((4 + (b) * 2 + (h)) * HTB)
#define PG8_STAGE(bufoff, gbase, voff) do { _Pragma("unroll") for (int _i = 0; _i < 2; ++_i) \
        __builtin_amdgcn_global_load_lds((const unsigned*)((const char*)(gbase) + (size_t)_i * p2##voff + (v##voff)), (PG8_LAS unsigned*)(lds + (bufoff) + ldsw + _i * 8192), 16, 0, 0); } while (0)
#define PG8_LDA(dst, b, h) do { _Pragma("unroll") for (int m = 0; m < 4; ++m) _Pragma("unroll") for (int k = 0; k < 2; ++k) dst[m][k] = *(const PG8_LAS bf16x8*)(lds + PG8_SA(b, h) + aoff + m * 2048 + k * 1024); } while (0)
#define PG8_LDB(dst, b, h) do { _Pragma("unroll") for (int n = 0; n < 2; ++n) _Pragma("unroll") for (int k = 0; k < 2; ++k) dst[n][k] = *(const PG8_LAS bf16x8*)(lds + PG8_SB(b, h) + boff + n * 2048 + k * 1024); } while (0)
#define PG8_MMA(ai, bj, At, Bt) do { __builtin_amdgcn_s_setprio(1); _Pragma("unroll") for (int m = 0; m < 4; ++m) _Pragma("unroll") for (int n = 0; n < 2; ++n) _Pragma("unroll") for (int k = 0; k < 2; ++k) \
        acc[ai][bj][m][n] = __builtin_amdgcn_mfma_f32_16x16x32_bf16(Bt[n][k], At[m][k], acc[ai][bj][m][n], 0, 0, 0); __builtin_amdgcn_s_setprio(0); } while (0)
#define PG8_WAIT_V(n) asm volatile("s_waitcnt vmcnt(" #n ")" ::: "memory")
#define PG8_WAIT_L(n) asm volatile("s_waitcnt lgkmcnt(" #n ")" ::: "memory")
#define PG8_BAR __builtin_amdgcn_s_barrier()
#define PG8_SCHED __builtin_amdgcn_sched_barrier(0)
    Unit cur, nxt; int ui = 0;
    if (!S.next(0, cur)) return;
    f32x4 acc[2][2][4][2];
#pragma unroll
    for (int a = 0; a < 2; ++a)
#pragma unroll
        for (int b = 0; b < 2; ++b)
#pragma unroll
            for (int m = 0; m < 4; ++m)
#pragma unroll
                for (int n = 0; n < 2; ++n) acc[a][b][m][n] = (f32x4){0.f, 0.f, 0.f, 0.f};
    bf16x8 At[4][2], B0[2][2], B1[2][2];
    const char* cA = (const char*)g.A + (size_t)cur.pm * tstepA; const char* cB = (const char*)g.Bt + (size_t)cur.pn * tstepB;
    S.a_ready(cur);
    if constexpr (SP2) {
        PG8_STAGE(PG8_SB(0, 0), cB, offB); PG8_STAGE(PG8_SB(0, 1), cB + hstepB, offB); PG8_STAGE(PG8_SA(0, 0), cA, offA); PG8_STAGE(PG8_SA(0, 1), cA + hstepA, offA);
        if (wr == 1) PG8_BAR;
        PG8_WAIT_V(2); PG8_BAR;
        PG8_STAGE(PG8_SB(1, 0), cB + kstep, offB); PG8_STAGE(PG8_SA(1, 0), cA + kstep, offA); PG8_STAGE(PG8_SB(1, 1), cB + hstepB + kstep, offB);
        PG8_WAIT_V(6); PG8_BAR;
    } else {
        PG8_STAGE(PG8_SB(0, 0), cB, offB); PG8_STAGE(PG8_SA(0, 0), cA, offA); PG8_STAGE(PG8_SB(0, 1), cB + hstepB, offB); PG8_STAGE(PG8_SA(0, 1), cA + hstepA, offA);
        if (wr == 1) PG8_BAR;
        PG8_WAIT_V(4); PG8_BAR;
        PG8_STAGE(PG8_SB(1, 0), cB + kstep, offB); PG8_STAGE(PG8_SA(1, 0), cA + kstep, offA); PG8_STAGE(PG8_SB(1, 1), cB + hstepB + kstep, offB);
        PG8_WAIT_V(6); PG8_BAR;
    }
    for (;;) {
        const bool has_next = S.next(ui + 1, nxt);
        const char* nA = has_next ? (const char*)g.A + (size_t)nxt.pm * tstepA : cA; const char* nB = has_next ? (const char*)g.Bt + (size_t)nxt.pn * tstepB : cB;
        for (int t = 0; t < nt; t += 2) {
            const bool last = (t == nt - 2);
            const char* a1 = cA + (size_t)(t + 1) * kstep;
            const char* a2 = last ? nA : cA + (size_t)(t + 2) * kstep; const char* b2 = last ? nB : cB + (size_t)(t + 2) * kstep;
            const char* a3 = a2 + kstep; const char* b3 = b2 + kstep;
            if (last && has_next) S.a_ready(nxt);
            if constexpr (SP2) {
            PG8_LDB(B0, 0, 0); PG8_LDB(B1, 0, 1); PG8_SCHED; PG8_LDA(At, 0, 0); PG8_STAGE(PG8_SA(1, 1), a1 + hstepA, offA);
            PG8_WAIT_V(8); PG8_WAIT_L(0); PG8_BAR; PG8_MMA(0, 0, At, B0); PG8_MMA(0, 1, At, B1); PG8_BAR; PG8_SCHED;
            PG8_LDA(At, 0, 1); PG8_STAGE(PG8_SB(0, 0), b2, offB); PG8_STAGE(PG8_SB(0, 1), b2 + hstepB, offB); PG8_STAGE(PG8_SA(0, 0), a2, offA);
            PG8_WAIT_V(8); PG8_WAIT_L(0); PG8_BAR; PG8_MMA(1, 0, At, B0); PG8_MMA(1, 1, At, B1); PG8_BAR; PG8_SCHED;
            PG8_LDB(B0, 1, 0); PG8_LDB(B1, 1, 1); PG8_SCHED; PG8_LDA(At, 1, 0); PG8_STAGE(PG8_SA(0, 1), a2 + hstepA, offA);
            PG8_WAIT_V(8); PG8_WAIT_L(0); PG8_BAR; PG8_MMA(0, 0, At, B0); PG8_MMA(0, 1, At, B1); PG8_BAR; PG8_SCHED;
            PG8_LDA(At, 1, 1); PG8_STAGE(PG8_SB(1, 0), b3, offB); PG8_STAGE(PG8_SB(1, 1), b3 + hstepB, offB); PG8_STAGE(PG8_SA(1, 0), a3, offA);
            PG8_WAIT_V(8); PG8_WAIT_L(0); PG8_BAR; PG8_MMA(1, 0, At, B0); PG8_MMA(1, 1, At, B1); PG8_BAR; PG8_SCHED;
            } else {
            PG8_LDB(B0, 0, 0); PG8_SCHED; PG8_LDA(At, 0, 0); PG8_STAGE(PG8_SA(1, 1), a1 + hstepA, offA);
            PG8_WAIT_L(8); PG8_BAR; PG8_WAIT_L(0); PG8_MMA(0, 0, At, B0); PG8_BAR; PG8_SCHED;
            PG8_LDB(B1, 0, 1); PG8_STAGE(PG8_SB(0, 0), b2, offB);
            PG8_BAR; PG8_WAIT_L(0); PG8_MMA(0, 1, At, B1); PG8_BAR;
            PG8_LDA(At, 0, 1); PG8_STAGE(PG8_SA(0, 0), a2, offA);
            PG8_BAR; PG8_WAIT_L(0); PG8_MMA(1, 0, At, B0); PG8_BAR; PG8_SCHED;
            PG8_STAGE(PG8_SB(0, 1), b2 + hstepB, offB);
            PG8_WAIT_V(6); PG8_BAR; PG8_MMA(1, 1, At, B1); PG8_BAR;
            PG8_LDB(B0, 1, 0); PG8_SCHED; PG8_LDA(At, 1, 0); PG8_STAGE(PG8_SA(0, 1), a2 + hstepA, offA);
            PG8_WAIT_L(8); PG8_BAR; PG8_WAIT_L(0); PG8_MMA(0, 0, At, B0); PG8_BAR; PG8_SCHED;
            PG8_LDB(B1, 1, 1); PG8_STAGE(PG8_SB(1, 0), b3, offB);
            PG8_BAR; PG8_WAIT_L(0); PG8_MMA(0, 1, At, B1); PG8_BAR;
            PG8_LDA(At, 1, 1); PG8_STAGE(PG8_SA(1, 0), a3, offA);
            PG8_BAR; PG8_WAIT_L(0); PG8_MMA(1, 0, At, B0); PG8_BAR; PG8_SCHED;
            PG8_STAGE(PG8_SB(1, 1), b3 + hstepB, offB);
            PG8_WAIT_V(6); PG8_BAR; PG8_MMA(1, 1, At, B1); PG8_BAR;
            }
        }
        if constexpr (ALIGN_EPI) { if (wr == 0) PG8_BAR; }
        if constexpr (!Epi::AFTER_DRAIN) { E(acc, cur, wr, wc, fr, fq); S.done(cur); }
        if (!has_next) break;
#pragma unroll
        for (int a = 0; a < 2; ++a)
#pragma unroll
            for (int b = 0; b < 2; ++b)
#pragma unroll
                for (int m = 0; m < 4; ++m)
#pragma unroll
                    for (int n = 0; n < 2; ++n) acc[a][b][m][n] = (f32x4){0.f, 0.f, 0.f, 0.f};
        cur = nxt; cA = nA; cB = nB; ++ui;
        if constexpr (ALIGN_EPI) { if (wr == 1) PG8_BAR; }
    }
    PG8_WAIT_V(0);
    if constexpr (!ALIGN_EPI) { if (wr == 0) PG8_BAR; }
    PG8_BAR;
    if constexpr (Epi::AFTER_DRAIN) { E.fused(acc, cur, wr, wc, fr, fq, lds, wid, lane); S.done(cur); }
#undef PG8_SA
#undef PG8_SB
#undef PG8_STAGE
#undef PG8_LDA
#undef PG8_LDB
#undef PG8_MMA
#undef PG8_WAIT_V
#undef PG8_WAIT_L
#undef PG8_BAR
#undef PG8_SCHED
}
}

#define LAS __attribute__((address_space(3)))
typedef unsigned short bf16_t;
typedef short bf16x8 __attribute__((ext_vector_type(8)));
typedef float f32x4 __attribute__((ext_vector_type(4)));
typedef unsigned u32x4 __attribute__((ext_vector_type(4)));
typedef unsigned u32x2 __attribute__((ext_vector_type(2)));

constexpr int NTOK = 16384, DM = 1024, SEQ = 2048;
constexpr int A_IN = 5120, B_IN = 3072, OUT_K = 1536;
constexpr float EPS = 1e-6f;
constexpr float LOG2E = 1.4426950408889634f;
constexpr size_t MiB = 1u << 20;
constexpr size_t WS_WA_IN = 1 * MiB, WS_WA_OUT = 21 * MiB, WS_MKV = 27 * MiB, WS_XN = 43 * MiB, WS_Z = 75 * MiB, WS_SBUF = 236 * MiB, WS_DBUF = 252 * MiB, WS_END = 253 * MiB;
constexpr size_t ZT_WMEM = 0, ZT_MEMHAT = 8 * MiB;
constexpr size_t ZB_WIN0 = 96 * MiB, ZB_WIN1 = 103 * MiB, ZB_WOUT = 109 * MiB, ZB_COS = 115 * MiB, ZB_SIN = 117 * MiB, ZB_KV = 119 * MiB;
constexpr int LDS_BYTES = 147456;

#define XB_TMO      128
#define XB_XCNT(j)  (256  + 64 * (j))
#define XB_XSUB(j)  (1280 + 64 * (j))
#define XB_XGEN(j)  (2304 + 64 * (j))
#define XB_TOP      3328
#define XB_TOPGEN   3392
#define XCD_BAR_WORDS 3456
#define XB_SPIN_CAP (1u << 18)

__device__ __forceinline__ unsigned xb_ld(unsigned* p)              { return __hip_atomic_load(p, __ATOMIC_RELAXED, __HIP_MEMORY_SCOPE_AGENT); }
__device__ __forceinline__ unsigned xb_add(unsigned* p, unsigned v) { return __hip_atomic_fetch_add(p, v, __ATOMIC_RELAXED, __HIP_MEMORY_SCOPE_AGENT); }
__device__ __forceinline__ unsigned xb_xcc_id() { return (unsigned)__builtin_amdgcn_s_getreg((3 << 11) | 20) & 0xFu; }
#define XB_SPIN(cond, bar) do { unsigned _sp = 0; while (cond) { __builtin_amdgcn_s_sleep(1); \
    if ((++_sp & 255u) == 0u) { if (xb_ld(&(bar)[XB_TMO])) break; if (_sp > XB_SPIN_CAP) { atomicAdd(&(bar)[XB_TMO], 1u); break; } } } } while (0)

struct XcdBarrier {
    unsigned* bar; unsigned x;
    volatile LAS unsigned* st;
};

__device__ __forceinline__ XcdBarrier xcd_barrier_post(unsigned* bar, volatile LAS unsigned* st) {
    XcdBarrier b; b.bar = bar; b.x = xb_xcc_id(); b.st = st;
    if (threadIdx.x == 0) (void)xb_add(&bar[XB_XCNT(b.x)], 1u);
    return b;
}
__device__ __forceinline__ void xcd_barrier_complete(unsigned* bar, unsigned x, unsigned& nloc, unsigned& nx) {
    const unsigned G = gridDim.x * gridDim.y * gridDim.z;
    unsigned sum, cnt, mine, sp = 0u;
    for (;;) {
        sum = 0u; cnt = 0u; mine = 0u;
#pragma unroll
        for (unsigned j = 0; j < 16; ++j) { const unsigned c = xb_ld(&bar[XB_XCNT(j)]); sum += c; cnt += (c > 0u) ? 1u : 0u; mine = (j == x) ? c : mine; }
        if (sum == G) break;
        __builtin_amdgcn_s_sleep(1);
        if ((++sp & 255u) == 0u) { if (xb_ld(&bar[XB_TMO])) break; if (sp > XB_SPIN_CAP) { atomicAdd(&bar[XB_TMO], 1u); break; } }
    }
    nloc = mine > 0u ? mine : 1u; nx = cnt > 0u ? cnt : 1u;
}

__device__ __forceinline__ void xcd_barrier(const XcdBarrier& b) {
    asm volatile("s_waitcnt vmcnt(0)" ::: "memory");
    __syncthreads();
    if (threadIdx.x == 0) {
        unsigned* bar = b.bar;
        __builtin_amdgcn_s_waitcnt(0);
        unsigned nloc = b.st[0], nx = b.st[1];
        if (nloc == 0u) { xcd_barrier_complete(bar, b.x, nloc, nx); b.st[0] = nloc; b.st[1] = nx; }
        const unsigned old = xb_add(&bar[XB_XSUB(b.x)], 1u);
        const unsigned gen = old / nloc;
        if (old + 1u == (gen + 1u) * nloc) {
            __builtin_amdgcn_fence(__ATOMIC_RELEASE, "agent");
            asm volatile("s_waitcnt vmcnt(0)" ::: "memory");
            const unsigned og = xb_add(&bar[XB_TOP], 1u);
            const unsigned tg = og / nx;
            if (og + 1u == (tg + 1u) * nx) xb_add(&bar[XB_TOPGEN], 1u);
            else XB_SPIN(xb_ld(&bar[XB_TOPGEN]) == tg, bar);
            __builtin_amdgcn_fence(__ATOMIC_ACQUIRE, "agent");
            xb_add(&bar[XB_XGEN(b.x)], 1u);
            asm volatile("s_waitcnt vmcnt(0)" ::: "memory");
        } else {
            XB_SPIN(xb_ld(&bar[XB_XGEN(b.x)]) == gen, bar);
            __builtin_amdgcn_fence(__ATOMIC_ACQUIRE, "agent");
            asm volatile("s_waitcnt vmcnt(0)" ::: "memory");
        }
    }
    __syncthreads();
}


__device__ __forceinline__ float bf2f(unsigned short u) { return __uint_as_float((unsigned)u << 16); }
__device__ __forceinline__ unsigned pk2(float lo, float hi) { return pg8::cvt_pk_bf16(lo, hi); }
__device__ __forceinline__ float wave_sum(float v) {
#pragma unroll
    for (int o = 1; o < 64; o <<= 1) v += __shfl_xor(v, o);
    return v;
}
__device__ __forceinline__ float fast_exp2(float x) { return __builtin_amdgcn_exp2f(x); }
__device__ __forceinline__ float fast_rcp(float x) { return __builtin_amdgcn_rcpf(x); }
__device__ __forceinline__ float silu_f(float x) { return x * fast_rcp(1.0f + fast_exp2(-x * LOG2E)); }
__device__ __forceinline__ f32x4 mfma16(bf16x8 a, bf16x8 b, f32x4 c) { return __builtin_amdgcn_mfma_f32_16x16x32_bf16(a, b, c, 0, 0, 0); }

struct EpiGen {
    static constexpr bool PERM = true, AFTER_DRAIN = false;
    bf16_t* O; int ldc; int mode; unsigned char* wsz;
    __device__ __forceinline__ void operator()(const pg8::f32x4 (&acc)[2][2][4][2], const pg8::Unit& u, int wr, int wc, int fr, int fq) const {
        const int row0 = u.pm * 256 + wr * 64 + fr;
        int colt = u.pn * 256; bf16_t* base = O; int ld = ldc; bool rope = false;
        if (mode == 1) { if (u.pn < 4) rope = true; else if (u.pn >= 12) { base = (bf16_t*)(wsz + ZB_KV); ld = 512; colt = (u.pn - 12) * 256; rope = (u.pn == 12); } }
        const int col0 = colt + wc * 32 + 8 * fq;
        if (rope) {
            const int i0 = (col0 & 63) >> 1; const float* cosT = (const float*)(wsz + ZB_COS); const float* sinT = (const float*)(wsz + ZB_SIN);
#pragma unroll
            for (int ai = 0; ai < 2; ++ai)
#pragma unroll
                for (int m = 0; m < 4; ++m) {
                    const int row = row0 + ai * 128 + m * 16;
                    const f32x4 cs = *(const f32x4*)(cosT + (size_t)row * 32 + i0), sn = *(const f32x4*)(sinT + (size_t)row * 32 + i0);
                    bf16_t* rowp = base + (size_t)row * ld + col0;
#pragma unroll
                    for (int bj = 0; bj < 2; ++bj) {
                        const f32x4 v0 = acc[ai][bj][m][0], v1 = acc[ai][bj][m][1];
                        u32x4 w;
                        w.x = pk2(v0[0] * cs[0] - v0[1] * sn[0], v0[1] * cs[0] + v0[0] * sn[0]);
                        w.y = pk2(v0[2] * cs[1] - v0[3] * sn[1], v0[3] * cs[1] + v0[2] * sn[1]);
                        w.z = pk2(v1[0] * cs[2] - v1[1] * sn[2], v1[1] * cs[2] + v1[0] * sn[2]);
                        w.w = pk2(v1[2] * cs[3] - v1[3] * sn[3], v1[3] * cs[3] + v1[2] * sn[3]);
                        *(u32x4*)(rowp + bj * 128) = w;
                    }
                }
        } else {
#pragma unroll
            for (int ai = 0; ai < 2; ++ai)
#pragma unroll
                for (int m = 0; m < 4; ++m) {
                    bf16_t* rowp = base + (size_t)(row0 + ai * 128 + m * 16) * ld + col0;
#pragma unroll
                    for (int bj = 0; bj < 2; ++bj) {
                        const f32x4 v0 = acc[ai][bj][m][0], v1 = acc[ai][bj][m][1];
                        u32x4 w; w.x = pk2(v0[0], v0[1]); w.y = pk2(v0[2], v0[3]); w.z = pk2(v1[0], v1[1]); w.w = pk2(v1[2], v1[3]);
                        *(u32x4*)(rowp + bj * 128) = w;
                    }
                }
        }
    }
};

__device__ __forceinline__ void transpose_item(const float* W, int K, int N, bf16_t* WT, int row_off, const float* gain, int perm_lim, LAS float* scr, int item, int lane) {
    const int nblk = N / 32, kb = item / nblk, nb = item % nblk, k0 = 64 * kb, n0 = 32 * nb;
#pragma unroll 8
    for (int i = 0; i < 32; ++i) { const int kk = 2 * i + (lane >> 5); const float gk = gain ? gain[k0 + kk] : 1.0f; scr[kk * 33 + (lane & 31)] = W[(size_t)(k0 + kk) * N + n0 + (lane & 31)] * gk; }
    asm volatile("s_waitcnt lgkmcnt(0)" ::: "memory");
    const int c = lane & 7;
#pragma unroll
    for (int j = 0; j < 4; ++j) {
        const int n = (lane >> 3) + 8 * j; const LAS float* s = scr + (8 * c) * 33 + n;
        u32x4 o; o.x = pk2(s[0 * 33], s[1 * 33]); o.y = pk2(s[2 * 33], s[3 * 33]); o.z = pk2(s[4 * 33], s[5 * 33]); o.w = pk2(s[6 * 33], s[7 * 33]);
        const int ng = n0 + n; const int dst = (ng < perm_lim) ? ((ng & ~63) + 2 * (ng & 31) + ((ng >> 5) & 1)) : ng;
        *(u32x4*)(WT + (size_t)(row_off + dst) * K + k0 + 8 * c) = o;
    }
    asm volatile("s_waitcnt lgkmcnt(0)" ::: "memory");
}
__device__ __forceinline__ void xhat_row(const float* xrow, bf16_t* orow, int lane) {
    const f32x4* xr = (const f32x4*)xrow + lane; f32x4 v[4]; float s = 0.f;
#pragma unroll
    for (int j = 0; j < 4; ++j) { v[j] = xr[64 * j]; s += (v[j][0] * v[j][0] + v[j][1] * v[j][1]) + (v[j][2] * v[j][2] + v[j][3] * v[j][3]); }
    const float r = 1.0f / sqrtf(wave_sum(s) * (1.0f / 1024.0f) + EPS);
    u32x2* o = (u32x2*)orow + lane;
#pragma unroll
    for (int j = 0; j < 4; ++j) { u32x2 w; w.x = pk2(v[j][0] * r, v[j][1] * r); w.y = pk2(v[j][2] * r, v[j][3] * r); o[64 * j] = w; }
}
__device__ __forceinline__ void norm_row(const bf16_t* yrow, const float* hin, const float* gpost, float* hout, bf16_t* xnrow, bool write_xn, int lane, bool dry) {
    const u32x2* yr = (const u32x2*)yrow + lane; f32x4 y[4]; float s = 0.f;
#pragma unroll
    for (int j = 0; j < 4; ++j) { const u32x2 w = yr[64 * j]; y[j][0] = __uint_as_float(w.x << 16); y[j][1] = __uint_as_float(w.x & 0xffff0000u); y[j][2] = __uint_as_float(w.y << 16); y[j][3] = __uint_as_float(w.y & 0xffff0000u);
        s += (y[j][0] * y[j][0] + y[j][1] * y[j][1]) + (y[j][2] * y[j][2] + y[j][3] * y[j][3]); }
    const float r = 1.0f / sqrtf(wave_sum(s) * (1.0f / 1024.0f) + EPS);
    const f32x4* hr = (const f32x4*)hin + lane; const f32x4* gr = (const f32x4*)gpost + lane; f32x4* ho = (f32x4*)hout + lane; float s2 = 0.f;
#pragma unroll
    for (int j = 0; j < 4; ++j) { const f32x4 h = hr[64 * j] + y[j] * r * gr[64 * j]; y[j] = h; if (!dry) ho[64 * j] = h; s2 += (h[0] * h[0] + h[1] * h[1]) + (h[2] * h[2] + h[3] * h[3]); }
    if (write_xn && !dry) {
        const float r2 = 1.0f / sqrtf(wave_sum(s2) * (1.0f / 1024.0f) + EPS);
        u32x2* o = (u32x2*)xnrow + lane;
#pragma unroll
        for (int j = 0; j < 4; ++j) { u32x2 w; w.x = pk2(y[j][0] * r2, y[j][1] * r2); w.y = pk2(y[j][2] * r2, y[j][3] * r2); o[64 * j] = w; }
    }
}

template <int D, int NK, bool SWA>
__device__ __forceinline__ void attn_rowtile2(const LAS unsigned char* Kl, const LAS unsigned char* VT, const bf16_t* qptr, const bf16_t* gptr, bf16_t* optr, float sc2, float sink2, int irow, bool first_blk, int c, int g, bool dry) {
    constexpr int KSTR = (D + 8) * 2, VSTR = (NK + 8) * 2, NKT = NK / 16, NKK = D / 32, NDT = D / 16, NK2 = NK / 32;
    bf16x8 qf[NKK];
#pragma unroll
    for (int kk = 0; kk < NKK; ++kk) qf[kk] = *(const bf16x8*)(qptr + kk * 32 + g * 8);
    f32x4 st[NKT];
#pragma unroll
    for (int kt = 0; kt < NKT; ++kt) {
        f32x4 a = {0.f, 0.f, 0.f, 0.f};
#pragma unroll
        for (int kk = 0; kk < NKK; ++kk) { const bf16x8 kf = *(const LAS bf16x8*)(Kl + (16 * kt + c) * KSTR + kk * 64 + g * 16); a = mfma16(kf, qf[kk], a); }
        st[kt] = a;
    }
    float m = -INFINITY;
#pragma unroll
    for (int kt = 0; kt < NKT; ++kt)
#pragma unroll
        for (int r = 0; r < 4; ++r) {
            float x = st[kt][r] * sc2;
            if (SWA) { const int j = 16 * kt + 4 * g + r; const bool ok = (j > irow) && (j <= irow + 128) && (!first_blk || j >= 128); x = ok ? x : -INFINITY; }
            st[kt][r] = x; m = fmaxf(m, x);
        }
    m = fmaxf(m, __shfl_xor(m, 16)); m = fmaxf(m, __shfl_xor(m, 32));
    if (SWA) m = fmaxf(m, sink2);
    float l = 0.f;
#pragma unroll
    for (int kt = 0; kt < NKT; ++kt)
#pragma unroll
        for (int r = 0; r < 4; ++r) { const float p = fast_exp2(st[kt][r] - m); st[kt][r] = p; l += p; }
    l += __shfl_xor(l, 16); l += __shfl_xor(l, 32);
    if (SWA) l += fast_exp2(sink2 - m);
    const float inv = 1.0f / l;
    bf16x8 pf[NK2];
#pragma unroll
    for (int k2 = 0; k2 < NK2; ++k2) {
        u32x4 w; w.x = pk2(st[2 * k2][0], st[2 * k2][1]); w.y = pk2(st[2 * k2][2], st[2 * k2][3]); w.z = pk2(st[2 * k2 + 1][0], st[2 * k2 + 1][1]); w.w = pk2(st[2 * k2 + 1][2], st[2 * k2 + 1][3]);
        pf[k2] = __builtin_bit_cast(bf16x8, w);
    }
#pragma unroll
    for (int dt = 0; dt < NDT; ++dt) {
        f32x4 a = {0.f, 0.f, 0.f, 0.f};
#pragma unroll
        for (int k2 = 0; k2 < NK2; ++k2) {
            const LAS unsigned char* vp = VT + (16 * dt + c) * VSTR + (32 * k2 + 4 * g) * 2;
            const u32x2 lo = *(const LAS u32x2*)vp, hi = *(const LAS u32x2*)(vp + 32);
            u32x4 w; w.x = lo.x; w.y = lo.y; w.z = hi.x; w.w = hi.y;
            a = mfma16(__builtin_bit_cast(bf16x8, w), pf[k2], a);
        }
        const u32x2 gw = *(const u32x2*)(gptr + 16 * dt + 4 * g);
        const float g0 = __uint_as_float(gw.x << 16), g1 = __uint_as_float(gw.x & 0xffff0000u), g2 = __uint_as_float(gw.y << 16), g3 = __uint_as_float(gw.y & 0xffff0000u);
        u32x2 o; o.x = pk2(a[0] * inv * silu_f(g0), a[1] * inv * silu_f(g1)); o.y = pk2(a[2] * inv * silu_f(g2), a[3] * inv * silu_f(g3));
        if (!dry) *(u32x2*)(optr + 16 * dt + 4 * g) = o;
    }
}

__device__ __forceinline__ void vt_scatter(LAS unsigned char* vt_base, int vstr, u32x4 v) {
    LAS unsigned short* p = (LAS unsigned short*)vt_base; const int s = vstr >> 1;
    p[0 * s] = (unsigned short)(v.x & 0xffffu); p[1 * s] = (unsigned short)(v.x >> 16); p[2 * s] = (unsigned short)(v.y & 0xffffu); p[3 * s] = (unsigned short)(v.y >> 16);
    p[4 * s] = (unsigned short)(v.z & 0xffffu); p[5 * s] = (unsigned short)(v.z >> 16); p[6 * s] = (unsigned short)(v.w & 0xffffu); p[7 * s] = (unsigned short)(v.w >> 16);
}
__device__ __forceinline__ void mem_unit(LAS unsigned char* lds, int u, int l, const bf16_t* MKV, bf16_t* Z, int ldz, int qcol, int gcol, int tid, bool dry) {
    constexpr int D = 128, NK = 256, KSTR = (D + 8) * 2, VSTR = (NK + 8) * 2;
    LAS unsigned char* Kl = lds; LAS unsigned char* VT = lds + NK * KSTR;
    const int tile = u >> 2, hm = u & 3, b = tile >> 3;
    const bf16_t* kv = MKV + (size_t)(b * 256) * 4096 + l * 1024 + hm * 128;
#pragma unroll 4
    for (int i = 0; i < 8; ++i) {
        const int p = tid + 512 * i, key = p >> 4, c8 = p & 15;
        const u32x4 kq = *(const u32x4*)(kv + (size_t)key * 4096 + c8 * 8);
        const u32x4 vq = *(const u32x4*)(kv + (size_t)key * 4096 + 512 + c8 * 8);
        *(LAS u32x4*)(Kl + key * KSTR + c8 * 16) = kq;
        vt_scatter(VT + (c8 * 8) * VSTR + key * 2, VSTR, vq);
    }
    __syncthreads();
    const int w = tid >> 6, lane = tid & 63, c = lane & 15, g = lane >> 4;
    const float sc2 = 0.08838834764831845f * LOG2E;
#pragma unroll 1
    for (int rt = 0; rt < 2; ++rt) {
        const int tok = tile * 256 + w * 32 + rt * 16 + c;
        bf16_t* row = Z + (size_t)tok * ldz;
        attn_rowtile2<D, NK, false>(Kl, VT, row + qcol + hm * 128, row + gcol + hm * 128, row + qcol + hm * 128, sc2, 0.f, 0, false, c, g, dry);
    }
    __syncthreads();
}
__device__ __forceinline__ void swa_unit(LAS unsigned char* lds, int u, const bf16_t* KV, bf16_t* Z, const float* sinks, int tid, bool dry) {
    constexpr int D = 64, NK = 256, KSTR = (D + 8) * 2, VSTR = (NK + 8) * 2;
    LAS unsigned char* Kl = lds; LAS unsigned char* VT = lds + NK * KSTR;
    const int nb = u & 15, kvh = (u >> 4) & 3, b = u >> 6;
#pragma unroll
    for (int i = 0; i < 4; ++i) {
        const int p = tid + 512 * i, key = p >> 3, c8 = p & 7, pos = (nb - 1) * 128 + key;
        u32x4 kq = {0u, 0u, 0u, 0u}, vq = {0u, 0u, 0u, 0u};
        if (pos >= 0) { const bf16_t* src = KV + (size_t)(b * SEQ + pos) * 512 + kvh * 64 + c8 * 8; kq = *(const u32x4*)src; vq = *(const u32x4*)(src + 256); }
        *(LAS u32x4*)(Kl + key * KSTR + c8 * 16) = kq;
        vt_scatter(VT + (c8 * 8) * VSTR + key * 2, VSTR, vq);
    }
    __syncthreads();
    const int w = tid >> 6, lane = tid & 63, c = lane & 15, g = lane >> 4;
    const int hq = kvh * 4 + (w >> 1);
    const float sink2 = sinks[hq] * LOG2E;
#pragma unroll 1
    for (int rt = 0; rt < 4; ++rt) {
        const int i = (w & 1) * 64 + rt * 16 + c;
        bf16_t* row = Z + (size_t)(b * SEQ + nb * 128 + i) * B_IN;
        attn_rowtile2<D, NK, true>(Kl, VT, row + hq * 64, row + 1024 + hq * 64, row + 1024 + hq * 64, 0.125f * LOG2E, sink2, i, nb == 0, c, g, dry);
    }
    __syncthreads();
}
__device__ __forceinline__ void hgrn_unit(LAS unsigned char* lds, bf16_t* Zb, int h, int layer, const float* lblog, const float* gnorm, int tid, bool dry,
                                          int seg, bool state_only, float* Sb  , float* Db  ) {
    constexpr int L_RAWQ = 0, L_RAWF = 16384, L_OBUF = 0, L_RAWG = 32768, L_VT = 49152, L_QH = 67584, L_QT = 84992, L_KT = 102400, L_KHT = 119808, L_P15 = 144384;
    constexpr int VTS = 144, QS = 272;
    const int lane = tid & 63, w = tid >> 6, c = lane & 15, g = lane >> 4;
    const int kc = tid & 127, blk = tid >> 7;
    float lbv;
    { const int chn = h * 128 + kc; const float a0 = lblog[chn], a1 = lblog[1024 + chn], a2 = lblog[2048 + chn]; const float mx = fmaxf(a0, fmaxf(a1, a2));
      const float e0 = expf(a0 - mx), e1 = expf(a1 - mx), e2 = expf(a2 - mx); lbv = (layer == 0 ? e0 : e0 + e1) / (e0 + e1 + e2); }
    const float oml = 1.0f - lbv;
    const int t4 = tid >> 3, vs = (tid & 7) * 16;
    f32x4 S[8];
#pragma unroll
    for (int i = 0; i < 8; ++i) S[i] = (f32x4){0.f, 0.f, 0.f, 0.f};
    if (!state_only) {
#pragma unroll 1
        for (int j = 0; j < seg; ++j) {
            const float* sj = Sb + (size_t)j * 16384; const float* dj = Db + j * 512;
            if (tid < 128) *(LAS float*)(lds + L_P15 + tid * 4) = (dj[tid] * dj[128 + tid]) * (dj[256 + tid] * dj[384 + tid]);
            __syncthreads();
#pragma unroll
            for (int kt = 0; kt < 8; ++kt) {
                const f32x4 d4 = *(const LAS f32x4*)(lds + L_P15 + (16 * kt + 4 * g) * 4);
                S[kt] = S[kt] * d4 + *(const f32x4*)(sj + tid * 32 + kt * 4);
            }
            __syncthreads();
        }
    }
    float dprod = 1.0f;
    u32x4 rq[2], rf[2], rv[2], rg[2];
    const bf16_t* zh = Zb + (size_t)(seg * 512) * A_IN + h * 128;
#pragma unroll
    for (int i = 0; i < 2; ++i) { const int p = tid + 512 * i, row = p >> 4, c8 = p & 15; const bf16_t* src = zh + (size_t)row * A_IN + c8 * 8;
        rf[i] = *(const u32x4*)(src + 1024); rv[i] = *(const u32x4*)(src + 2048);
        if (!state_only) { rq[i] = *(const u32x4*)src; rg[i] = *(const u32x4*)(src + 3072); } else { rq[i] = rf[i]; rg[i] = rf[i]; } }
#pragma unroll 1
    for (int ch = 0; ch < 8; ++ch) {
#pragma unroll
        for (int i = 0; i < 2; ++i) { const int p = tid + 512 * i, row = p >> 4, c8 = p & 15;
            *(LAS u32x4*)(lds + L_RAWF + row * 256 + c8 * 16) = rf[i];
            if (!state_only) { *(LAS u32x4*)(lds + L_RAWQ + row * 256 + c8 * 16) = rq[i]; *(LAS u32x4*)(lds + L_RAWG + row * 256 + c8 * 16) = rg[i]; }
            vt_scatter(lds + L_VT + (c8 * 8) * VTS + row * 2, VTS, rv[i]); }
        if (ch + 1 < 8) {
#pragma unroll
            for (int i = 0; i < 2; ++i) { const int p = tid + 512 * i, row = p >> 4, c8 = p & 15; const bf16_t* src = zh + (size_t)((ch + 1) * 64 + row) * A_IN + c8 * 8;
                rf[i] = *(const u32x4*)(src + 1024); rv[i] = *(const u32x4*)(src + 2048);
                if (!state_only) { rq[i] = *(const u32x4*)src; rg[i] = *(const u32x4*)(src + 3072); } }
        }
        __syncthreads();
        {
            float f[16], kh[16];
            const LAS unsigned short* rF = (const LAS unsigned short*)(lds + L_RAWF) + (16 * blk) * 128 + kc;
#pragma unroll
            for (int s = 0; s < 16; ++s) {
                float fp = bf2f(rF[s * 128]); fp = fminf(fmaxf(fp, -30.f), 30.f);
                const float e = fast_exp2(-fp * LOG2E), sg = fast_rcp(1.0f + e);
                f[s] = lbv + oml * sg; kh[s] = oml * (e * sg);
            }
            float suf = 1.0f;
#pragma unroll
            for (int s = 15; s >= 0; --s) { kh[s] *= suf; suf *= f[s]; }
            const float P15 = fmaxf(suf, 1e-30f);
            dprod *= P15;
            u32x4 k0, k1; k0.x = pk2(kh[0], kh[1]); k0.y = pk2(kh[2], kh[3]); k0.z = pk2(kh[4], kh[5]); k0.w = pk2(kh[6], kh[7]);
            k1.x = pk2(kh[8], kh[9]); k1.y = pk2(kh[10], kh[11]); k1.z = pk2(kh[12], kh[13]); k1.w = pk2(kh[14], kh[15]);
            *(LAS u32x4*)(lds + L_KHT + (blk * 128 + kc) * 48) = k0; *(LAS u32x4*)(lds + L_KHT + (blk * 128 + kc) * 48 + 16) = k1;
            *(LAS float*)(lds + L_P15 + (blk * 128 + kc) * 4) = P15;
            if (!state_only) {
                const LAS unsigned short* rQ = (const LAS unsigned short*)(lds + L_RAWQ) + (16 * blk) * 128 + kc;
                float run = 1.0f;
#pragma unroll
                for (int s = 0; s < 16; ++s) { run *= f[s]; f[s] = run; }
                const float P7 = fmaxf(f[7], 1e-30f), iP7 = fast_rcp(P7), c1 = P7 * fast_rcp(P15);
                LAS unsigned short* qh = (LAS unsigned short*)(lds + L_QH) + (16 * blk) * (QS / 2) + kc;
                LAS unsigned short* qt = (LAS unsigned short*)(lds + L_QT) + (16 * blk) * (QS / 2) + kc;
                LAS unsigned short* kt = (LAS unsigned short*)(lds + L_KT) + (16 * blk) * (QS / 2) + kc;
#pragma unroll
                for (int s = 0; s < 16; ++s) {
                    const float qhv = silu_f(bf2f(rQ[s * 128])) * f[s], qtv = qhv * iP7, ktv = kh[s] * c1;
                    const unsigned w01 = pk2(qhv, qtv), w2 = pk2(ktv, ktv);
                    qh[s * (QS / 2)] = (unsigned short)w01; qt[s * (QS / 2)] = (unsigned short)(w01 >> 16); kt[s * (QS / 2)] = (unsigned short)w2;
                }
            }
        }
        __syncthreads();
#pragma unroll 1
        for (int b2 = 0; b2 < 4; ++b2) {
            const int tb = 16 * b2;
            if (!state_only) {
                f32x4 aS = {0.f, 0.f, 0.f, 0.f};
#pragma unroll
                for (int k4 = 0; k4 < 4; ++k4) {
                    const bf16x8 a = *(const LAS bf16x8*)(lds + L_KT + (tb + c) * QS + k4 * 64 + g * 16);
                    const bf16x8 b = *(const LAS bf16x8*)(lds + L_QT + (tb + c) * QS + k4 * 64 + g * 16);
                    aS = mfma16(a, b, aS);
                }
#pragma unroll
                for (int r = 0; r < 4; ++r) if (4 * g + r > c) aS[r] = 0.f;
                u32x4 pw; pw.x = pk2(aS[0], aS[1]); pw.y = pk2(aS[2], aS[3]); pw.z = 0u; pw.w = 0u;
                const u32x2 vv = *(const LAS u32x2*)(lds + L_VT + (16 * w + c) * VTS + (tb + 4 * g) * 2);
                u32x4 vw; vw.x = vv.x; vw.y = vv.y; vw.z = 0u; vw.w = 0u;
                f32x4 aO = mfma16(__builtin_bit_cast(bf16x8, pw), __builtin_bit_cast(bf16x8, vw), (f32x4){0.f, 0.f, 0.f, 0.f});
                f32x4 aO2 = {0.f, 0.f, 0.f, 0.f};
#pragma unroll
                for (int k4 = 0; k4 < 4; ++k4) {
                    const LAS unsigned char* qp = lds + L_QH + (tb + c) * QS + (32 * k4 + 4 * g) * 2;
                    const u32x2 q0 = *(const LAS u32x2*)qp, q1 = *(const LAS u32x2*)(qp + 32);
                    u32x4 qa; qa.x = q0.x; qa.y = q0.y; qa.z = q1.x; qa.w = q1.y;
                    u32x4 sb; sb.x = pk2(S[2 * k4][0], S[2 * k4][1]); sb.y = pk2(S[2 * k4][2], S[2 * k4][3]); sb.z = pk2(S[2 * k4 + 1][0], S[2 * k4 + 1][1]); sb.w = pk2(S[2 * k4 + 1][2], S[2 * k4 + 1][3]);
                    if (k4 & 1) aO2 = mfma16(__builtin_bit_cast(bf16x8, qa), __builtin_bit_cast(bf16x8, sb), aO2);
                    else aO = mfma16(__builtin_bit_cast(bf16x8, qa), __builtin_bit_cast(bf16x8, sb), aO);
                }
                aO = aO + aO2;
#pragma unroll
                for (int r = 0; r < 4; ++r) *(LAS float*)(lds + L_OBUF + ((tb + 4 * g + r) * 128 + 16 * w + c) * 4) = aO[r];
            }
            u32x4 vb = {0u, 0u, 0u, 0u};
            if (g < 2) vb = *(const LAS u32x4*)(lds + L_VT + (16 * w + c) * VTS + (tb + 8 * g) * 2);
#pragma unroll
            for (int kt = 0; kt < 8; ++kt) {
                const f32x4 p = *(const LAS f32x4*)(lds + L_P15 + (b2 * 128 + 16 * kt + 4 * g) * 4);
                u32x4 ka = {0u, 0u, 0u, 0u};
                if (g < 2) ka = *(const LAS u32x4*)(lds + L_KHT + (b2 * 128 + 16 * kt + c) * 48 + g * 16);
                S[kt] = mfma16(__builtin_bit_cast(bf16x8, ka), __builtin_bit_cast(bf16x8, vb), S[kt] * p);
            }
        }
        __syncthreads();
        if (!state_only) {
            f32x4 o[4]; float ss = 0.f;
#pragma unroll
            for (int i = 0; i < 4; ++i) { o[i] = *(const LAS f32x4*)(lds + L_OBUF + (t4 * 128 + vs + 4 * i) * 4); ss += (o[i][0] * o[i][0] + o[i][1] * o[i][1]) + (o[i][2] * o[i][2] + o[i][3] * o[i][3]); }
            ss += __shfl_xor(ss, 1); ss += __shfl_xor(ss, 2); ss += __shfl_xor(ss, 4);
            const float r = 1.0f / sqrtf(ss * (1.0f / 128.0f) + EPS);
            const u32x4 ga = *(const LAS u32x4*)(lds + L_RAWG + t4 * 256 + vs * 2), gb = *(const LAS u32x4*)(lds + L_RAWG + t4 * 256 + vs * 2 + 16);
            const unsigned gwv[8] = {ga.x, ga.y, ga.z, ga.w, gb.x, gb.y, gb.z, gb.w};
            unsigned ow[8];
#pragma unroll
            for (int i = 0; i < 8; ++i) {
                const float g0 = __uint_as_float(gwv[i] << 16), g1 = __uint_as_float(gwv[i] & 0xffff0000u);
                const float o0 = o[i >> 1][(i & 1) * 2], o1 = o[i >> 1][(i & 1) * 2 + 1];
                const f32x4 gn = *(const f32x4*)(gnorm + vs + 4 * (i >> 1));
                const float n0 = gn[(i & 1) * 2], n1 = gn[(i & 1) * 2 + 1];
                ow[i] = pk2(o0 * r * n0 * silu_f(g0), o1 * r * n1 * silu_f(g1));
            }
            bf16_t* dst = Zb + (size_t)(seg * 512 + ch * 64 + t4) * A_IN + 3072 + h * 128 + vs;
            u32x4 w0, w1; w0.x = ow[0]; w0.y = ow[1]; w0.z = ow[2]; w0.w = ow[3]; w1.x = ow[4]; w1.y = ow[5]; w1.z = ow[6]; w1.w = ow[7];
            if (!dry) { *(u32x4*)dst = w0; *(u32x4*)(dst + 8) = w1; }
            __syncthreads();
        }
    }
    if (state_only && !dry) {
        float* sj = Sb + (size_t)seg * 16384;
#pragma unroll
        for (int kt = 0; kt < 8; ++kt) *(f32x4*)(sj + tid * 32 + kt * 4) = S[kt];
        Db[seg * 512 + blk * 128 + kc] = dprod;
    }
}

struct Args { const float* in[16]; float* out; unsigned char* ws; int ph_lo, ph_hi, probe, pad; };
constexpr int N_PHASES = 20;

__global__ void __launch_bounds__(512, 2) fwd_kernel(Args a) {
    extern __shared__ __attribute__((aligned(16))) unsigned char lds_raw[];
    LAS unsigned char* lds = (LAS unsigned char*)lds_raw;
    cg::grid_group grid = cg::this_grid();
    const int G = gridDim.x, bx = blockIdx.x;
    unsigned char* ws = a.ws;
    bf16_t* Z = (bf16_t*)(ws + WS_Z); bf16_t* XN = (bf16_t*)(ws + WS_XN); bf16_t* MKV = (bf16_t*)(ws + WS_MKV);

    volatile LAS unsigned* bst = (volatile LAS unsigned*)(lds + LDS_BYTES - 64);
    if (threadIdx.x < 2) bst[threadIdx.x] = 0u;
    __syncthreads();
    const XcdBarrier xbar = xcd_barrier_post((unsigned*)ws, bst);
#pragma unroll 1
    for (int ph = a.ph_lo; ph < a.ph_hi; ++ph) {
        int kind, l;
        if (ph < 2) { kind = ph; l = 0; }
        else if (ph < 12) { l = (ph - 2) / 5; const int s5 = (ph - 2) % 5; kind = (s5 == 0) ? 2 : (s5 == 1) ? 3 : (s5 == 2) ? 4 : (s5 == 3) ? 5 : 6; }
        else { l = 2 + ((ph - 12) >> 2); const int s4 = (ph - 12) & 3; kind = (s4 == 0) ? 2 : (s4 == 1) ? 7 : (s4 == 2) ? 5 : 6; }
        const bool is_gemm = (kind == 1) || (kind == 2) || (kind == 5);
        const int cls = (kind <= 1) ? 6 : (kind == 2) ? 1 : (kind == 5) ? 2 : (kind == 3) ? 3 : (kind == 4) ? 8 : (kind == 7) ? 4 : 5;
        const int nrep = (a.probe == cls) ? 2 : 1;
#pragma unroll 1
        for (int rep = 0; rep < nrep; ++rep) {
        const bool dry = rep + 1 < nrep;
        int tid = threadIdx.x; asm volatile("" : "+v"(tid));
        const int lane = tid & 63, wave = __builtin_amdgcn_readfirstlane(tid >> 6);
        const int gw = bx * 8 + wave, NGW = G * 8;
        LAS float* scr = (LAS float*)(lds + wave * 16384);
        if (ph == 0) {
            constexpr int I_IN = 16 * 160, I_OUT = 24 * 32, I_MEM = 16 * 32, NIT = 2 * I_IN + 2 * I_OUT + 4 * I_MEM;
            for (int it = gw; it < NIT; it += NGW) {
                int r = it;
                if (r < 2 * I_IN) { const int li = r / I_IN; r -= li * I_IN;
                    transpose_item(a.in[7] + (size_t)li * DM * A_IN, DM, A_IN, (bf16_t*)(ws + WS_WA_IN) + (size_t)li * A_IN * DM, 0, a.in[3] + li * DM, 0, scr, r, lane); continue; }
                r -= 2 * I_IN;
                if (r < 2 * I_OUT) { const int li = r / I_OUT; r -= li * I_OUT;
                    transpose_item(a.in[10] + (size_t)li * OUT_K * DM, OUT_K, DM, (bf16_t*)(ws + WS_WA_OUT) + (size_t)li * DM * OUT_K, 0, nullptr, 0, scr, r, lane); continue; }
                r -= 2 * I_OUT;
                { const int li = r / I_MEM; r -= li * I_MEM;
                    transpose_item(a.in[6] + (size_t)li * DM * 1024, DM, 1024, (bf16_t*)(ws + WS_Z + ZT_WMEM), li * 1024, a.in[5] + li * DM, 0, scr, r, lane); }
            }
            for (int m = gw; m < NTOK; m += NGW) xhat_row(a.in[0] + (size_t)m * DM, XN + (size_t)m * DM, lane);
            for (int m = gw; m < 2048; m += NGW) xhat_row(a.in[1] + (size_t)m * DM, (bf16_t*)(ws + WS_Z + ZT_MEMHAT) + (size_t)m * DM, lane);
        } else if (is_gemm) {
            pg8::Gemm gm; EpiGen E; E.mode = 0; E.wsz = ws + WS_Z;
            if (ph == 1) { gm.A = (const bf16_t*)(ws + WS_Z + ZT_MEMHAT); gm.Bt = (const bf16_t*)(ws + WS_Z + ZT_WMEM); gm.M = 2048; gm.N = 4096; gm.K = 1024; gm.lda = 1024; E.O = MKV; E.ldc = 4096; }
            else if (kind == 2) {
                gm.A = XN; gm.M = NTOK; gm.K = DM; gm.lda = DM; E.O = Z;
                if (l < 2) { gm.Bt = (const bf16_t*)(ws + WS_WA_IN) + (size_t)l * A_IN * DM; gm.N = A_IN; E.ldc = A_IN; }
                else { gm.Bt = (const bf16_t*)(ws + WS_Z + (l == 2 ? ZB_WIN0 : ZB_WIN1)); gm.N = (l == 2) ? 3584 : 3072; E.ldc = B_IN; E.mode = 1; }
            } else {
                gm.M = NTOK; gm.N = DM; gm.K = OUT_K; E.O = XN; E.ldc = DM;
                if (l < 2) { gm.A = Z + 3072; gm.lda = A_IN; gm.Bt = (const bf16_t*)(ws + WS_WA_OUT) + (size_t)l * DM * OUT_K; }
                else { gm.A = Z + 1024; gm.lda = B_IN; gm.Bt = (const bf16_t*)(ws + WS_Z + ZB_WOUT) + (size_t)(l - 2) * DM * OUT_K; }
            }
            pg8::StaticOrder S; S.init(gm.M, gm.N, G, bx);
            if (gm.K == 1024) pg8::gemm_phase<EpiGen, pg8::StaticOrder, true, true, 1024, 1024>(lds, gm, S, E);
            else if (gm.lda == A_IN) pg8::gemm_phase<EpiGen, pg8::StaticOrder, true, true, 1536, A_IN>(lds, gm, S, E);
            else pg8::gemm_phase<EpiGen, pg8::StaticOrder, true, true, 1536, B_IN>(lds, gm, S, E);
        } else if (kind == 3 || kind == 4) {
            if (kind == 3) for (int u = bx; u < 256; u += G) mem_unit(lds, u, l, MKV, Z, A_IN, 4096, 4608, tid, dry);
            for (int u = bx; u < 256; u += G) {
                const int seg = u & 3, bh = u >> 2;
                if (kind == 4 || seg < 3)
                    hgrn_unit(lds, Z + (size_t)(bh >> 3) * SEQ * A_IN, bh & 7, l, a.in[8], a.in[9] + l * 1024 + (bh & 7) * 128, tid, dry, seg, kind == 3,
                              (float*)(ws + WS_SBUF) + (size_t)bh * 65536, (float*)(ws + WS_DBUF) + (size_t)bh * 2048);
            }
        } else if (kind == 7) {
            for (int u = bx; u < 768; u += G) {
                if (u < 512) swa_unit(lds, u, (const bf16_t*)(ws + WS_Z + ZB_KV), Z, a.in[14] + (l - 2) * 16, tid, dry);
                else mem_unit(lds, u - 512, l, MKV, Z, B_IN, 2048, 2560, tid, dry);
            }
        } else {
            const float* hin = (l == 0) ? a.in[0] : a.out;
            for (int m = gw; m < NTOK; m += NGW) norm_row(XN + (size_t)m * DM, hin + (size_t)m * DM, a.in[4] + l * DM, a.out + (size_t)m * DM, XN + (size_t)m * DM, l < 3, lane, dry);
            if (l == 1) {
                constexpr int I_BIN = 16 * 96, I_KV = 16 * 16, I_OUT = 24 * 32, NIT = 2 * I_BIN + I_KV + 2 * I_OUT;
                for (int it = gw; it < NIT; it += NGW) {
                    int r = it;
                    if (r < I_BIN) { transpose_item(a.in[13], DM, B_IN, (bf16_t*)(ws + WS_Z + ZB_WIN0), 0, a.in[3] + 2 * DM, 1024, scr, r, lane); continue; } r -= I_BIN;
                    if (r < I_KV) { transpose_item(a.in[12], DM, 512, (bf16_t*)(ws + WS_Z + ZB_WIN0), 3072, a.in[11], 256, scr, r, lane); continue; } r -= I_KV;
                    if (r < I_BIN) { transpose_item(a.in[13] + (size_t)DM * B_IN, DM, B_IN, (bf16_t*)(ws + WS_Z + ZB_WIN1), 0, a.in[3] + 3 * DM, 1024, scr, r, lane); continue; } r -= I_BIN;
                    { const int li = r / I_OUT; r -= li * I_OUT;
                      transpose_item(a.in[15] + (size_t)li * OUT_K * DM, OUT_K, DM, (bf16_t*)(ws + WS_Z + ZB_WOUT) + (size_t)li * DM * OUT_K, 0, nullptr, 0, scr, r, lane); }
                }
                const int* pos = (const int*)a.in[2]; float* cT = (float*)(ws + WS_Z + ZB_COS); float* sT = (float*)(ws + WS_Z + ZB_SIN);
                for (int e = bx * 512 + tid; e < NTOK * 32; e += G * 512) {
                    const int i = e & 31; const float inv_freq = exp2f(-(float)(2 * i) * (13.287712379549449f / 64.0f));
                    const float ang = (float)pos[e >> 5] * inv_freq;
                    cT[e] = cosf(ang); sT[e] = sinf(ang);
                }
            }
        }
        }
        if (ph + 1 < a.ph_hi) { if (a.probe == 99) grid.sync(); else xcd_barrier(xbar); }
    }
}

#ifndef MK_PER_PHASE
#define MK_PER_PHASE 0
#endif
#define MK_PROBE 0
extern "C" void kernel_launch(void* const* d_in, const int* in_sizes, int n_in, void* d_out, int out_size, void* d_ws, size_t ws_size, hipStream_t stream) {
    static int grid = 0;
    if (grid == 0) {
        if (n_in != 16 || ws_size < WS_END) { fprintf(stderr, "kernel_launch: unexpected n_in %d / ws %zu\n", n_in, ws_size); grid = -1; return; }
        if (hipFuncSetAttribute((const void*)fwd_kernel, hipFuncAttributeMaxDynamicSharedMemorySize, LDS_BYTES) != hipSuccess) { fprintf(stderr, "hipFuncSetAttribute failed\n"); grid = -1; return; }
        int dev = 0, cus = 0, per_cu = 0;
        hipGetDevice(&dev); hipDeviceGetAttribute(&cus, hipDeviceAttributeMultiprocessorCount, dev);
        hipOccupancyMaxActiveBlocksPerMultiprocessor(&per_cu, (const void*)fwd_kernel, 512, LDS_BYTES);
        (void)hipGetLastError();
        grid = 256;
        if (per_cu < 1 || cus < 256) fprintf(stderr, "kernel_launch: occupancy %d x %d CUs < 256 workgroups\n", per_cu, cus);
    }
    if (grid < 0) return;
    if (hipMemsetAsync(d_ws, 0, 16384, stream) != hipSuccess) { fprintf(stderr, "memset failed\n"); return; }
    Args a{};
    for (int i = 0; i < 16; ++i) a.in[i] = (const float*)d_in[i];
    a.out = (float*)d_out; a.ws = (unsigned char*)d_ws;
#if MK_PER_PHASE
    for (int ph = 0; ph < N_PHASES; ++ph) { a.ph_lo = ph; a.ph_hi = ph + 1; hipLaunchKernelGGL(fwd_kernel, dim3(grid), dim3(512), LDS_BYTES, stream, a); }
#else
    a.ph_lo = 0; a.ph_hi = N_PHASES; a.probe = MK_PROBE;
    void* args[] = {&a};
    hipError_t e = hipLaunchCooperativeKernel((const void*)fwd_kernel, dim3(grid), dim3(512), args, LDS_BYTES, stream);
    if (e != hipSuccess) fprintf(stderr, "cooperative launch failed: %s\n", hipGetErrorString(e));
#endif
}
```
